# Optimizing an MI355X kernel written in HIP

```python
import math
import jax, jax.numpy as jnp
from jax import lax
import numpy as np


D_MODEL = 1024
BATCH = 2
SEQ = 8192
DEPTH = 4

HEAD_DIM = 64
N_HEADS = D_MODEL // HEAD_DIM
SWA_Q_HEADS = N_HEADS // 2
SWA_KV_HEADS = max(1, SWA_Q_HEADS // 4)
MOBA_HEADS = N_HEADS - SWA_Q_HEADS
SWA_WIDTH = SWA_Q_HEADS * HEAD_DIM
SWA_KV_WIDTH = SWA_KV_HEADS * HEAD_DIM
MOBA_WIDTH = MOBA_HEADS * HEAD_DIM
MIX_WIDTH = SWA_WIDTH + MOBA_WIDTH
IN_COLS = SWA_WIDTH + 2 * SWA_KV_WIDTH + 3 * MOBA_WIDTH
IN_SPLITS = (SWA_WIDTH,
             SWA_WIDTH + SWA_KV_WIDTH,
             SWA_WIDTH + 2 * SWA_KV_WIDTH,
             SWA_WIDTH + 2 * SWA_KV_WIDTH + MOBA_WIDTH,
             SWA_WIDTH + 2 * SWA_KV_WIDTH + 2 * MOBA_WIDTH)
SWA_WINDOW = 128
SWA_BLOCK = 128
MOBA_BLOCK = 256
MOBA_TOPK = 3
MOBA_Q_CHUNK = 128
T5_BUCKETS = 32
T5_MAX_DIST = 128
D_FF = ((8 * D_MODEL // 3 + 255) // 256) * 256
N_MOD = 9
EPS = 1e-6
NEG = -1e30

kernel_name = 'hybrid_swa_moba_macaron_trunk'


def rmsnorm(x, g):
    xf = x.astype(jnp.float32)
    y = xf * lax.rsqrt(jnp.mean(xf * xf, axis=-1, keepdims=True) + EPS)
    return (y * g.astype(jnp.float32)).astype(x.dtype)


def t5_bucket(dist):
    n = jnp.maximum(dist, 0)
    max_exact = T5_BUCKETS // 2
    nf = jnp.maximum(n, 1).astype(jnp.float32)
    large = max_exact + (jnp.log(nf / max_exact) / math.log(T5_MAX_DIST / max_exact)
                         * (T5_BUCKETS - max_exact)).astype(jnp.int32)
    large = jnp.minimum(large, T5_BUCKETS - 1)
    return jnp.where(n < max_exact, n, large)


def swiglu(h, w_gate, w_up, w_down):
    return (jax.nn.silu(h @ w_gate) * (h @ w_up)) @ w_down


def swa_attention(q, k, v, sinks, table):
    B_, S, Hq, dh = q.shape
    Hkv = k.shape[2]
    G = Hq // Hkv
    L = SWA_BLOCK
    nblk = S // L
    qb = q.reshape(B_, nblk, L, Hkv, G, dh)
    kb = k.reshape(B_, nblk, L, Hkv, dh)
    vb = v.reshape(B_, nblk, L, Hkv, dh)
    pad = ((0, 0), (1, 0), (0, 0), (0, 0), (0, 0))
    kw = jnp.concatenate([jnp.pad(kb, pad)[:, :-1], kb], axis=2)
    vw = jnp.concatenate([jnp.pad(vb, pad)[:, :-1], vb], axis=2)
    s = jnp.einsum('bnqhgd,bnkhd->bnhgqk', qb, kw).astype(jnp.float32) * (dh ** -0.5)
    qi = jnp.arange(L)[:, None]
    kj = jnp.arange(2 * L)[None, :]
    dist = qi + L - kj
    bias = table.T[:, t5_bucket(dist)].astype(jnp.float32).reshape(Hkv, G, L, 2 * L)
    kpos = jnp.arange(nblk)[:, None, None] * L - L + kj[None]
    valid = (dist >= 0)[None] & (dist < SWA_WINDOW)[None] & (kpos >= 0)
    s = jnp.where(valid[None, :, None, None], s + bias, NEG)
    sink = jnp.broadcast_to(sinks.astype(jnp.float32).reshape(1, 1, Hkv, G, 1, 1),
                            s.shape[:-1] + (1,))
    p = jax.nn.softmax(jnp.concatenate([s, sink], axis=-1), axis=-1)[..., :-1]
    o = jnp.einsum('bnhgqk,bnkhd->bnqhgd', p.astype(v.dtype), vw)
    return o.reshape(B_, S, Hq, dh)


def moba_attention(q, k, v, table):
    B_, S, H, dh = q.shape
    L = MOBA_BLOCK
    C = MOBA_Q_CHUNK
    nb = -(-S // L)
    Sp = nb * L
    padw = ((0, 0), (0, Sp - S), (0, 0), (0, 0))
    q, k, v = jnp.pad(q, padw), jnp.pad(k, padw), jnp.pad(v, padw)
    kb = k.reshape(B_, nb, L, H, dh).transpose(0, 3, 1, 2, 4)
    vb = v.reshape(B_, nb, L, H, dh).transpose(0, 3, 1, 2, 4)
    kmean = jnp.mean(kb, axis=3)
    topk = min(MOBA_TOPK, nb)
    nchunk = Sp // C
    qc = q.reshape(B_, nchunk, C, H, dh).transpose(1, 0, 3, 2, 4)
    scale = dh ** -0.5
    tableT = table.T.astype(jnp.float32)
    bi = jnp.arange(B_)[:, None, None, None]
    hi = jnp.arange(H)[None, :, None, None]
    hi5 = jnp.arange(H)[None, :, None, None, None]

    def chunk_fn(args):
        qblk, ci = args
        q_pos = ci * C + jnp.arange(C)
        cur = (ci * C) // L
        gate = jnp.einsum('bhcd,bhnd->bhcn', qblk, kmean)
        gate = jnp.where(jnp.arange(nb) < cur, gate, NEG)
        _, sel = lax.top_k(gate, topk)
        sel_ok = jnp.arange(topk) < cur
        k_sel = kb[bi, hi, sel]
        v_sel = vb[bi, hi, sel].reshape(B_, H, C, topk * L, dh)
        s_sel = jnp.einsum('bhcd,bhctld->bhctl', qblk, k_sel).astype(jnp.float32) * scale
        k_pos_sel = sel[..., None] * L + jnp.arange(L)
        dist_sel = q_pos[None, None, :, None, None] - k_pos_sel
        s_sel = s_sel + tableT[hi5, t5_bucket(dist_sel)]
        s_sel = jnp.where(sel_ok[None, None, None, :, None], s_sel, NEG)
        s_sel = s_sel.reshape(B_, H, C, topk * L)
        k_own = lax.dynamic_index_in_dim(kb, cur, axis=2, keepdims=False)
        v_own = lax.dynamic_index_in_dim(vb, cur, axis=2, keepdims=False)
        dist_own = q_pos[:, None] - (cur * L + jnp.arange(L))[None, :]
        s_own = jnp.einsum('bhcd,bhld->bhcl', qblk, k_own).astype(jnp.float32) * scale
        s_own = jnp.where(dist_own >= 0, s_own + tableT[:, t5_bucket(dist_own)], NEG)
        p = jax.nn.softmax(jnp.concatenate([s_sel, s_own], axis=-1), axis=-1).astype(v.dtype)
        o = (jnp.einsum('bhck,bhckd->bhcd', p[..., :topk * L], v_sel)
             + jnp.einsum('bhcl,bhld->bhcd', p[..., topk * L:], v_own))
        return o

    out = lax.map(chunk_fn, (qc, jnp.arange(nchunk)))
    out = out.transpose(1, 0, 3, 2, 4).reshape(B_, Sp, H, dh)
    return out[:, :S]


def hybrid_mixer(h, w_in, b_in, w_out, sinks, group_gain, rel_bias):
    B_, S, _ = h.shape
    proj = h @ w_in + b_in
    qa, ka, va, qb, kb, vb = jnp.split(proj, IN_SPLITS, axis=-1)
    qa = qa.reshape(B_, S, SWA_Q_HEADS, HEAD_DIM)
    ka = ka.reshape(B_, S, SWA_KV_HEADS, HEAD_DIM)
    va = va.reshape(B_, S, SWA_KV_HEADS, HEAD_DIM)
    qb = qb.reshape(B_, S, MOBA_HEADS, HEAD_DIM)
    kb = kb.reshape(B_, S, MOBA_HEADS, HEAD_DIM)
    vb = vb.reshape(B_, S, MOBA_HEADS, HEAD_DIM)
    ya = swa_attention(qa, ka, va, sinks, rel_bias[:, :SWA_Q_HEADS]).reshape(B_, S, SWA_WIDTH)
    yb = moba_attention(qb, kb, vb, rel_bias[:, SWA_Q_HEADS:]).reshape(B_, S, MOBA_WIDTH)
    y = jnp.concatenate([rmsnorm(ya, group_gain[:SWA_WIDTH]),
                         rmsnorm(yb, group_gain[SWA_WIDTH:])], axis=-1)
    return y @ w_out


def setup_inputs(seed: int = 0) -> dict:
    key = jax.random.key(seed)
    ks = jax.random.split(key, 16)
    f = jnp.float32

    def w(k, shape, fan_in, gain=1.0):
        return jax.random.normal(k, shape, f) * (gain * fan_in ** -0.5)

    return {
        'x': jax.random.normal(ks[0], (BATCH, SEQ, D_MODEL), f),
        'c': jax.random.normal(ks[1], (BATCH, D_MODEL), f),
        'rel_bias': 0.5 * jax.random.normal(ks[2], (T5_BUCKETS, N_HEADS), f),
        'ada_w': w(ks[3], (DEPTH, D_MODEL, N_MOD * D_MODEL), D_MODEL, 0.5),
        'ada_b': 0.01 * jax.random.normal(ks[4], (DEPTH, N_MOD * D_MODEL), f),
        'norm_pre': 1.0 + 0.05 * jax.random.normal(ks[5], (DEPTH, 3, D_MODEL), f),
        'norm_post': 1.0 + 0.05 * jax.random.normal(ks[6], (DEPTH, 3, D_MODEL), f),
        'ffn_w_gate': w(ks[7], (DEPTH, 2, D_MODEL, D_FF), D_MODEL),
        'ffn_w_up': w(ks[8], (DEPTH, 2, D_MODEL, D_FF), D_MODEL),
        'ffn_w_down': w(ks[9], (DEPTH, 2, D_FF, D_MODEL), D_FF),
        'mix_w_in': w(ks[10], (DEPTH, D_MODEL, IN_COLS), D_MODEL),
        'mix_b_in': 0.01 * jax.random.normal(ks[11], (DEPTH, IN_COLS), f),
        'mix_w_out': w(ks[12], (DEPTH, MIX_WIDTH, D_MODEL), MIX_WIDTH),
        'attn_sinks': jax.random.normal(ks[13], (DEPTH, SWA_Q_HEADS), f),
        'group_gain': 1.0 + 0.05 * jax.random.normal(ks[14], (DEPTH, MIX_WIDTH), f),
    }


def reference(x, c, rel_bias, ada_w, ada_b, norm_pre, norm_post, ffn_w_gate, ffn_w_up,
              ffn_w_down, mix_w_in, mix_b_in, mix_w_out, attn_sinks, group_gain):
    c_act = jax.nn.silu(c)
    for l in range(DEPTH):
        mod = (c_act @ ada_w[l] + ada_b[l])[:, None, :]
        sh1, sc1, g1, sh2, sc2, g2, sh3, sc3, g3 = jnp.split(mod, N_MOD, axis=-1)
        h = rmsnorm(x, norm_pre[l, 0]) * (1.0 + sc1) + sh1
        y = swiglu(h, ffn_w_gate[l, 0], ffn_w_up[l, 0], ffn_w_down[l, 0])
        x = x + 0.5 * g1 * rmsnorm(y, norm_post[l, 0])
        h = rmsnorm(x, norm_pre[l, 1]) * (1.0 + sc2) + sh2
        y = hybrid_mixer(h, mix_w_in[l], mix_b_in[l], mix_w_out[l], attn_sinks[l],
                         group_gain[l], rel_bias)
        x = x + g2 * rmsnorm(y, norm_post[l, 1])
        h = rmsnorm(x, norm_pre[l, 2]) * (1.0 + sc3) + sh3
        y = swiglu(h, ffn_w_gate[l, 1], ffn_w_up[l, 1], ffn_w_down[l, 1])
        x = x + 0.5 * g3 * rmsnorm(y, norm_post[l, 2])
    return x
```

```cpp
#include <hip/hip_runtime.h>
#include <cstdio>
#include <cstdint>
namespace pg8 {
#define PG8_LAS __attribute__((address_space(3)))
typedef unsigned short bf16_t;
typedef short bf16x8 __attribute__((ext_vector_type(8)));
typedef float f32x4 __attribute__((ext_vector_type(4)));
typedef unsigned u32x4 __attribute__((ext_vector_type(4)));
constexpr int BM = 256, BK = 64, HALF = 128, HTB = HALF * BK * 2  , STAGE_BYTES = 8 * HTB, NXCD = 8, WGM = 8;

__host__ __device__ __forceinline__ int lds_byte(int r, int c) { const int st = (r >> 4) * 2 + (c >> 5), rr = r & 15, cc = c & 31, ob = rr * 64 + cc * 2; return st * 1024 + (ob ^ (((ob >> 9) & 1) << 5)); }
__host__ __device__ __forceinline__ void stage_rc(int b, int& R, int& C) { const int st = b / 1024, sb = b % 1024, swz = sb ^ (((sb >> 9) & 1) << 5); R = (st >> 1) * 16 + swz / 64; C = (st & 1) * 32 + (swz % 64) / 2; }
__host__ __device__ __forceinline__ int perm32(int rho) { const int n = rho >> 4, i = rho & 15; return 8 * (i >> 2) + 4 * n + (i & 3); }

struct Unit { int pm, pn; };
struct Gemm { const bf16_t* A; const bf16_t* Bt; int M, N, K; };

struct StaticOrder {
    int nM, nN, nwg, G, c;
    __host__ __device__ void init(int M, int N, int G_, int c_) { nM = M / BM; nN = N / BM; nwg = nM * nN; G = G_; c = c_; }
    __host__ __device__ bool next(int i, Unit& u) const {
        const long L = (long)i * G + c; if (L >= nwg) return false;
        int wgid = (int)L; { const int q = nwg / NXCD, r = nwg % NXCD, xcd = wgid % NXCD, off = wgid / NXCD; wgid = (xcd < r ? xcd * (q + 1) : r * (q + 1) + (xcd - r) * q) + off; }
        const int nig = WGM * nN, gid = wgid / nig, fm = gid * WGM, gsz = (nM - fm) < WGM ? (nM - fm) : WGM;
        u.pm = fm + ((wgid % nig) % gsz); u.pn = (wgid % nig) / gsz; return true;
    }
    __device__ __forceinline__ void a_ready(const Unit&) const {}
    __device__ __forceinline__ void done(const Unit&) const {}
};

__device__ __forceinline__ unsigned cvt_pk_bf16(float lo, float hi) { unsigned r; asm volatile("v_cvt_pk_bf16_f32 %0, %1, %2" : "=v"(r) : "v"(lo), "v"(hi)); return r; }
typedef float f32x2 __attribute__((ext_vector_type(2)));

struct EpiSwiGLU {
    static constexpr bool PERM = true, AFTER_DRAIN = false;
    bf16_t* H; int ldh;
    __device__ __forceinline__ void operator()(const f32x4 (&acc)[2][2][4][2], const Unit& u, int wr, int wc, int fr, int fq) const {
        const int row0 = u.pm * BM + wr * 64 + fr; const int col0 = u.pn * HALF + wc * 32 + 8 * fq;
#pragma unroll
        for (int ai = 0; ai < 2; ++ai)
#pragma unroll
            for (int m = 0; m < 4; ++m) { bf16_t* rowp = H + (size_t)(row0 + ai * HALF + m * 16) * ldh + col0;
                float h[8];
#pragma unroll
                for (int n = 0; n < 2; ++n)
#pragma unroll
                    for (int j = 0; j < 4; ++j) { const float g = acc[ai][0][m][n][j], up = acc[ai][1][m][n][j];
                        const float sg = __builtin_amdgcn_rcpf(1.0f + __builtin_amdgcn_exp2f(-1.4426950408889634f * g));
                        h[n * 4 + j] = g * sg * up; }
                u32x4 w; w.x = cvt_pk_bf16(h[0], h[1]); w.y = cvt_pk_bf16(h[2], h[3]); w.z = cvt_pk_bf16(h[4], h[5]); w.w = cvt_pk_bf16(h[6], h[7]);
                *(u32x4*)rowp = w; }
    }
};
struct EpiBf16Bias {
    static constexpr bool PERM = true, AFTER_DRAIN = false;
    bf16_t* O; int ldc; const float* bias;
    __device__ __forceinline__ void operator()(const f32x4 (&acc)[2][2][4][2], const Unit& u, int wr, int wc, int fr, int fq) const {
        const int row0 = u.pm * BM + wr * 64 + fr; const int col0 = u.pn * BM + wc * 32 + 8 * fq;
        f32x4 bv[2][2];
#pragma unroll
        for (int bj = 0; bj < 2; ++bj)
#pragma unroll
            for (int n = 0; n < 2; ++n) bv[bj][n] = *(const f32x4*)(bias + col0 + bj * HALF + 4 * n);
#pragma unroll
        for (int ai = 0; ai < 2; ++ai)
#pragma unroll
            for (int m = 0; m < 4; ++m) { bf16_t* rowp = O + (size_t)(row0 + ai * HALF + m * 16) * ldc + col0;
#pragma unroll
                for (int bj = 0; bj < 2; ++bj) { const f32x4 v0 = acc[ai][bj][m][0] + bv[bj][0], v1 = acc[ai][bj][m][1] + bv[bj][1];
                    u32x4 w; w.x = cvt_pk_bf16(v0[0], v0[1]); w.y = cvt_pk_bf16(v0[2], v0[3]); w.z = cvt_pk_bf16(v1[0], v1[1]); w.w = cvt_pk_bf16(v1[2], v1[3]);
                    *(u32x4*)(rowp + bj * HALF) = w; } }
    }
};
struct EpiF32 {
    static constexpr bool PERM = false, AFTER_DRAIN = false;
    float* Y; int ldc;
    __device__ __forceinline__ void operator()(const f32x4 (&acc)[2][2][4][2], const Unit& u, int wr, int wc, int fr, int fq) const {
        const int row0 = u.pm * BM + wr * 64 + fr; const int col0 = u.pn * BM + wc * 32 + 4 * fq;
#pragma unroll
        for (int ai = 0; ai < 2; ++ai)
#pragma unroll
            for (int m = 0; m < 4; ++m) { float* rowp = Y + (size_t)(row0 + ai * HALF + m * 16) * ldc + col0;
#pragma unroll
                for (int bj = 0; bj < 2; ++bj)
#pragma unroll
                    for (int n = 0; n < 2; ++n) *(f32x4*)(rowp + bj * HALF + n * 16) = acc[ai][bj][m][n]; }
    }
};

template <class Epi, class Sched, bool ALIGN_EPI = false, bool SP2 = false>
__device__ __forceinline__ void gemm_phase(PG8_LAS unsigned char* lds, const Gemm g, const Sched& S, const Epi& E) {
    int tid_ = threadIdx.x; asm volatile("" : "+v"(tid_));
    const int tid = tid_, wid = __builtin_amdgcn_readfirstlane(tid >> 6), lane = tid & 63, wr = wid >> 2, wc = wid & 3, fr = lane & 15, fq = lane >> 4;
    const int K = g.K, nt = K / BK;
    unsigned voffA[2], voffB[2];
#pragma unroll
    for (int i = 0; i < 2; ++i) { int R, C; stage_rc(tid * 16 + i * 8192, R, C); const int Rb = Epi::PERM ? ((R & ~31) + perm32(R & 31)) : R;
        voffA[i] = (unsigned)(R * K + C) * 2u; voffB[i] = (unsigned)(Rb * K + C) * 2u; }
    const size_t kstep = (size_t)(BK * 2);
    const size_t hstep = (size_t)HALF * K * 2;
    const size_t tstep = 2 * hstep;
    const unsigned ldsw = (unsigned)wid * 1024u;
    const int aoff = lds_byte(wr * 64 + fr, fq * 8), boff = lds_byte(wc * 32 + fr, fq * 8);
#define PG8_SA(b, h) (((b) * 2 + (h)) * HTB)
#define PG8_SB(b, h) ((4 + (b) * 2 + (h)) * HTB)
#define PG8_STAGE(bufoff, gbase, voff) do { _Pragma("unroll") for (int _i = 0; _i < 2; ++_i) \
        __builtin_amdgcn_global_load_lds((const unsigned*)((const char*)(gbase) + (voff)[_i]), (PG8_LAS unsigned*)(lds + (bufoff) + ldsw + _i * 8192), 16, 0, 0); } while (0)
#define PG8_LDA(dst, b, h) do { _Pragma("unroll") for (int m = 0; m < 4; ++m) _Pragma("unroll") for (int k = 0; k < 2; ++k) dst[m][k] = *(const PG8_LAS bf16x8*)(lds + PG8_SA(b, h) + aoff + m * 2048 + k * 1024); } while (0)
#define PG8_LDB(dst, b, h) do { _Pragma("unroll") for (int n = 0; n < 2; ++n) _Pragma("unroll") for (int k = 0; k < 2; ++k) dst[n][k] = *(const PG8_LAS bf16x8*)(lds + PG8_SB(b, h) + boff + n * 2048 + k * 1024); } while (0)
#define PG8_MMA(ai, bj, At, Bt) do { __builtin_amdgcn_s_setprio(1); _Pragma("unroll") for (int m = 0; m < 4; ++m) _Pragma("unroll") for (int n = 0; n < 2; ++n) _Pragma("unroll") for (int k = 0; k < 2; ++k) \
        acc[ai][bj][m][n] = __builtin_amdgcn_mfma_f32_16x16x32_bf16(Bt[n][k], At[m][k], acc[ai][bj][m][n], 0, 0, 0); __builtin_amdgcn_s_setprio(0); } while (0)
#define PG8_WAIT_V(n) asm volatile("s_waitcnt vmcnt(" #n ")" ::: "memory")
#define PG8_WAIT_L(n) asm volatile("s_waitcnt lgkmcnt(" #n ")" ::: "memory")
#define PG8_BAR __builtin_amdgcn_s_barrier()
#define PG8_SCHED __builtin_amdgcn_sched_barrier(0)
    Unit cur, nxt; int ui = 0;
    if (!S.next(0, cur)) return;
    f32x4 acc[2][2][4][2];
#pragma unroll
    for (int a = 0; a < 2; ++a)
#pragma unroll
        for (int b = 0; b < 2; ++b)
#pragma unroll
            for (int m = 0; m < 4; ++m)
#pragma unroll
                for (int n = 0; n < 2; ++n) acc[a][b][m][n] = (f32x4){0.f, 0.f, 0.f, 0.f};
    bf16x8 At[4][2], B0[2][2], B1[2][2];
    const char* cA = (const char*)g.A + (size_t)cur.pm * tstep; const char* cB = (const char*)g.Bt + (size_t)cur.pn * tstep;
    S.a_ready(cur);
    if constexpr (SP2) {
        PG8_STAGE(PG8_SB(0, 0), cB, voffB); PG8_STAGE(PG8_SB(0, 1), cB + hstep, voffB); PG8_STAGE(PG8_SA(0, 0), cA, voffA); PG8_STAGE(PG8_SA(0, 1), cA + hstep, voffA);
        if (wr == 1) PG8_BAR;
        PG8_WAIT_V(2); PG8_BAR;
        PG8_STAGE(PG8_SB(1, 0), cB + kstep, voffB); PG8_STAGE(PG8_SA(1, 0), cA + kstep, voffA); PG8_STAGE(PG8_SB(1, 1), cB + hstep + kstep, voffB);
        PG8_WAIT_V(6); PG8_BAR;
    } else {
        PG8_STAGE(PG8_SB(0, 0), cB, voffB); PG8_STAGE(PG8_SA(0, 0), cA, voffA); PG8_STAGE(PG8_SB(0, 1), cB + hstep, voffB); PG8_STAGE(PG8_SA(0, 1), cA + hstep, voffA);
        if (wr == 1) PG8_BAR;
        PG8_WAIT_V(4); PG8_BAR;
        PG8_STAGE(PG8_SB(1, 0), cB + kstep, voffB); PG8_STAGE(PG8_SA(1, 0), cA + kstep, voffA); PG8_STAGE(PG8_SB(1, 1), cB + hstep + kstep, voffB);
        PG8_WAIT_V(6); PG8_BAR;
    }
    for (;;) {
        const bool has_next = S.next(ui + 1, nxt);
        const char* nA = has_next ? (const char*)g.A + (size_t)nxt.pm * tstep : cA; const char* nB = has_next ? (const char*)g.Bt + (size_t)nxt.pn * tstep : cB;
        for (int t = 0; t < nt; t += 2) {
            const bool last = (t == nt - 2);
            const char* a1 = cA + (size_t)(t + 1) * kstep;
            const char* a2 = last ? nA : cA + (size_t)(t + 2) * kstep; const char* b2 = last ? nB : cB + (size_t)(t + 2) * kstep;
            const char* a3 = a2 + kstep; const char* b3 = b2 + kstep;
            if (last && has_next) S.a_ready(nxt);
            if constexpr (SP2) {
            PG8_LDB(B0, 0, 0); PG8_LDB(B1, 0, 1); PG8_SCHED; PG8_LDA(At, 0, 0); PG8_STAGE(PG8_SA(1, 1), a1 + hstep, voffA);
            PG8_WAIT_V(8); PG8_WAIT_L(0); PG8_BAR; PG8_MMA(0, 0, At, B0); PG8_MMA(0, 1, At, B1); PG8_BAR; PG8_SCHED;
            PG8_LDA(At, 0, 1); PG8_STAGE(PG8_SB(0, 0), b2, voffB); PG8_STAGE(PG8_SB(0, 1), b2 + hstep, voffB); PG8_STAGE(PG8_SA(0, 0), a2, voffA);
            PG8_WAIT_V(8); PG8_WAIT_L(0); PG8_BAR; PG8_MMA(1, 0, At, B0); PG8_MMA(1, 1, At, B1); PG8_BAR; PG8_SCHED;
            PG8_LDB(B0, 1, 0); PG8_LDB(B1, 1, 1); PG8_SCHED; PG8_LDA(At, 1, 0); PG8_STAGE(PG8_SA(0, 1), a2 + hstep, voffA);
            PG8_WAIT_V(8); PG8_WAIT_L(0); PG8_BAR; PG8_MMA(0, 0, At, B0); PG8_MMA(0, 1, At, B1); PG8_BAR; PG8_SCHED;
            PG8_LDA(At, 1, 1); PG8_STAGE(PG8_SB(1, 0), b3, voffB); PG8_STAGE(PG8_SB(1, 1), b3 + hstep, voffB); PG8_STAGE(PG8_SA(1, 0), a3, voffA);
            PG8_WAIT_V(8); PG8_WAIT_L(0); PG8_BAR; PG8_MMA(1, 0, At, B0); PG8_MMA(1, 1, At, B1); PG8_BAR; PG8_SCHED;
            } else {
            PG8_LDB(B0, 0, 0); PG8_SCHED; PG8_LDA(At, 0, 0); PG8_STAGE(PG8_SA(1, 1), a1 + hstep, voffA);
            PG8_WAIT_L(8); PG8_BAR; PG8_WAIT_L(0); PG8_MMA(0, 0, At, B0); PG8_BAR; PG8_SCHED;
            PG8_LDB(B1, 0, 1); PG8_STAGE(PG8_SB(0, 0), b2, voffB);
            PG8_BAR; PG8_WAIT_L(0); PG8_MMA(0, 1, At, B1); PG8_BAR;
            PG8_LDA(At, 0, 1); PG8_STAGE(PG8_SA(0, 0), a2, voffA);
            PG8_BAR; PG8_WAIT_L(0); PG8_MMA(1, 0, At, B0); PG8_BAR; PG8_SCHED;
            PG8_STAGE(PG8_SB(0, 1), b2 + hstep, voffB);
            PG8_WAIT_V(6); PG8_BAR; PG8_MMA(1, 1, At, B1); PG8_BAR;
            PG8_LDB(B0, 1, 0); PG8_SCHED; PG8_LDA(At, 1, 0); PG8_STAGE(PG8_SA(0, 1), a2 + hstep, voffA);
            PG8_WAIT_L(8); PG8_BAR; PG8_WAIT_L(0); PG8_MMA(0, 0, At, B0); PG8_BAR; PG8_SCHED;
            PG8_LDB(B1, 1, 1); PG8_STAGE(PG8_SB(1, 0), b3, voffB);
            PG8_BAR; PG8_WAIT_L(0); PG8_MMA(0, 1, At, B1); PG8_BAR;
            PG8_LDA(At, 1, 1); PG8_STAGE(PG8_SA(1, 0), a3, voffA);
            PG8_BAR; PG8_WAIT_L(0); PG8_MMA(1, 0, At, B0); PG8_BAR; PG8_SCHED;
            PG8_STAGE(PG8_SB(1, 1), b3 + hstep, voffB);
            PG8_WAIT_V(6); PG8_BAR; PG8_MMA(1, 1, At, B1); PG8_BAR;
            }
        }
        if constexpr (ALIGN_EPI) { if (wr == 0) PG8_BAR; }
        if constexpr (!Epi::AFTER_DRAIN) { E(acc, cur, wr, wc, fr, fq); S.done(cur); }
        if (!has_next) break;
#pragma unroll
        for (int a = 0; a < 2; ++a)
#pragma unroll
            for (int b = 0; b < 2; ++b)
#pragma unroll
                for (int m = 0; m < 4; ++m)
#pragma unroll
                    for (int n = 0; n < 2; ++n) acc[a][b][m][n] = (f32x4){0.f, 0.f, 0.f, 0.f};
        cur = nxt; cA = nA; cB = nB; ++ui;
        if constexpr (ALIGN_EPI) { if (wr == 1) PG8_BAR; }
    }
    PG8_WAIT_V(0);
    if constexpr (!ALIGN_EPI) { if (wr == 0) PG8_BAR; }
    PG8_BAR;
    if constexpr (Epi::AFTER_DRAIN) { E.fused(acc, cur, wr, wc, fr, fq, lds, wid, lane); S.done(cur); }
#undef PG8_SA
#undef PG8_SB
#undef PG8_STAGE
#undef PG8_LDA
#undef PG8_LDB
#undef PG8_MMA
#undef PG8_WAIT_V
#undef PG8_WAIT_L
#undef PG8_BAR
#undef PG8_SCHED
}
}
#define GAS __attribute__((address_space(1)))
#define LAS __attribute__((address_space(3)))
typedef unsigned short bf16;
typedef unsigned v4u __attribute__((ext_vector_type(4)));
typedef float f32x4 __attribute__((ext_vector_type(4)));
typedef short bf16x8 __attribute__((ext_vector_type(8)));
typedef GAS unsigned gu32;
typedef GAS unsigned long long gu64;
#define RLX_AGENT __ATOMIC_RELAXED, __HIP_MEMORY_SCOPE_AGENT
#define LDS_WAIT() asm volatile("s_waitcnt lgkmcnt(0)" ::: "memory")
#define VM_WAIT() asm volatile("s_waitcnt vmcnt(0)" ::: "memory")
__device__ __forceinline__ unsigned long long rt() { return __builtin_amdgcn_s_memrealtime(); }
__device__ __forceinline__ unsigned f2bf(float f) { unsigned u = __builtin_bit_cast(unsigned, f); return (u + 0x7fffu + ((u >> 16) & 1u)) >> 16; }
__device__ __forceinline__ unsigned pk2(float lo, float hi) { return f2bf(lo) | (f2bf(hi) << 16); }

#define XB_TMO      128
#define XB_XCNT(j)  (256  + 64 * (j))
#define XB_XSUB(j)  (1280 + 64 * (j))
#define XB_XGEN(j)  (2304 + 64 * (j))
#define XB_TOP      3328
#define XB_TOPGEN   3392
#define XCD_BAR_WORDS 3456
#define XB_SPIN_CAP (1u << 18)

__device__ __forceinline__ unsigned xb_ld(unsigned* p)              { return __hip_atomic_load(p, __ATOMIC_RELAXED, __HIP_MEMORY_SCOPE_AGENT); }
__device__ __forceinline__ unsigned xb_add(unsigned* p, unsigned v) { return __hip_atomic_fetch_add(p, v, __ATOMIC_RELAXED, __HIP_MEMORY_SCOPE_AGENT); }
__device__ __forceinline__ unsigned xb_xcc_id() { return (unsigned)__builtin_amdgcn_s_getreg((3 << 11) | 20) & 0xFu; }
#define XB_SPIN(cond, bar) do { unsigned _sp = 0; while (cond) { __builtin_amdgcn_s_sleep(1); \
    if ((++_sp & 255u) == 0u) { if (xb_ld(&(bar)[XB_TMO])) break; if (_sp > XB_SPIN_CAP) { atomicAdd(&(bar)[XB_TMO], 1u); break; } } } } while (0)

struct XcdBarrier {
    unsigned* bar; unsigned x;
    volatile LAS unsigned* st;
};

__device__ __forceinline__ XcdBarrier xcd_barrier_post(unsigned* bar, volatile LAS unsigned* st) {
    XcdBarrier b; b.bar = bar; b.x = xb_xcc_id(); b.st = st;
    if (threadIdx.x == 0) (void)xb_add(&bar[XB_XCNT(b.x)], 1u);
    return b;
}
__device__ __forceinline__ void xcd_barrier_complete(unsigned* bar, unsigned x, unsigned& nloc, unsigned& nx) {
    const unsigned G = gridDim.x * gridDim.y * gridDim.z;
    unsigned sum, cnt, mine, sp = 0u;
    for (;;) {
        sum = 0u; cnt = 0u; mine = 0u;
#pragma unroll
        for (unsigned j = 0; j < 16; ++j) { const unsigned c = xb_ld(&bar[XB_XCNT(j)]); sum += c; cnt += (c > 0u) ? 1u : 0u; mine = (j == x) ? c : mine; }
        if (sum == G) break;
        __builtin_amdgcn_s_sleep(1);
        if ((++sp & 255u) == 0u) { if (xb_ld(&bar[XB_TMO])) break; if (sp > XB_SPIN_CAP) { atomicAdd(&bar[XB_TMO], 1u); break; } }
    }
    nloc = mine > 0u ? mine : 1u; nx = cnt > 0u ? cnt : 1u;
}

__device__ __forceinline__ void xcd_barrier(const XcdBarrier& b) {
    asm volatile("s_waitcnt vmcnt(0)" ::: "memory");
    __syncthreads();
    if (threadIdx.x == 0) {
        unsigned* bar = b.bar;
        __builtin_amdgcn_s_waitcnt(0);
        unsigned nloc = b.st[0], nx = b.st[1];
        if (nloc == 0u) { xcd_barrier_complete(bar, b.x, nloc, nx); b.st[0] = nloc; b.st[1] = nx; }
        const unsigned old = xb_add(&bar[XB_XSUB(b.x)], 1u);
        const unsigned gen = old / nloc;
        if (old + 1u == (gen + 1u) * nloc) {
            __builtin_amdgcn_fence(__ATOMIC_RELEASE, "agent");
            asm volatile("s_waitcnt vmcnt(0)" ::: "memory");
            const unsigned og = xb_add(&bar[XB_TOP], 1u);
            const unsigned tg = og / nx;
            if (og + 1u == (tg + 1u) * nx) xb_add(&bar[XB_TOPGEN], 1u);
            else XB_SPIN(xb_ld(&bar[XB_TOPGEN]) == tg, bar);
            __builtin_amdgcn_fence(__ATOMIC_ACQUIRE, "agent");
            xb_add(&bar[XB_XGEN(b.x)], 1u);
            asm volatile("s_waitcnt vmcnt(0)" ::: "memory");
        } else {
            XB_SPIN(xb_ld(&bar[XB_XGEN(b.x)]) == gen, bar);
            __builtin_amdgcn_fence(__ATOMIC_ACQUIRE, "agent");
            asm volatile("s_waitcnt vmcnt(0)" ::: "memory");
        }
    }
    __syncthreads();
}

constexpr int NWAVES = 8, NTHR = NWAVES * 64;
constexpr int BATCH = 2, SEQ = 8192, D = 1024, M = BATCH * SEQ, DEPTH = 4, FF = 2816, NGU = 2 * FF, INC = 2304, NMOD = 9 * D;
constexpr int QA_OFF = 0, KA_OFF = 512, VA_OFF = 640, QB_OFF = 768, KB_OFF = 1280, VB_OFF = 1792;
constexpr float EPS = 1e-6f;
constexpr size_t MiB = 1u << 20;
constexpr size_t WS_CTL = 0, CTL_ZERO_BYTES = 1 * MiB;
constexpr size_t WS_MODP = 2 * MiB;
constexpr size_t WS_MOD = 8 * MiB;
constexpr size_t WS_KMEAN = 9 * MiB;
constexpr size_t WS_W = 16 * MiB;
constexpr size_t W_GU = (size_t)NGU * D * 2, W_D = (size_t)D * FF * 2, W_IN = (size_t)INC * D * 2, W_OUT = (size_t)D * D * 2;
constexpr size_t W_LAYER = 2 * W_GU + 2 * W_D + W_IN + W_OUT;
constexpr size_t WS_XN = 176 * MiB;
constexpr size_t WS_H = 208 * MiB;
constexpr size_t WS_Y = 296 * MiB;
constexpr size_t WS_QKV = 360 * MiB;
constexpr size_t WS_O = 432 * MiB;
constexpr size_t WS_END = 464 * MiB;
static_assert(WS_W + DEPTH * W_LAYER <= WS_XN && WS_H + (size_t)M * FF * 2 <= WS_Y && WS_QKV + (size_t)M * INC * 2 <= WS_O, "d_ws map");
constexpr int CW_BAR = 4096;
constexpr int RING_OFF = 0, RING_BYTES = 131072;
constexpr int LDSCTL_OFF = RING_BYTES, MISC_OFF = LDSCTL_OFF + 320;
constexpr int CACT_OFF = RING_BYTES + 1024;
constexpr int LDS_BYTES = 147456;
static_assert(CACT_OFF + 8192 <= LDS_BYTES, "LDS map");

typedef unsigned long long u64;
typedef unsigned u32x2 __attribute__((ext_vector_type(2)));
__device__ __forceinline__ float bflo(unsigned w) { return __uint_as_float(w << 16); }
__device__ __forceinline__ float bfhi(unsigned w) { return __uint_as_float(w & 0xffff0000u); }
__device__ __forceinline__ void unpack8(const v4u w, float (&f)[8]) { f[0] = bflo(w.x); f[1] = bfhi(w.x); f[2] = bflo(w.y); f[3] = bfhi(w.y); f[4] = bflo(w.z); f[5] = bfhi(w.z); f[6] = bflo(w.w); f[7] = bfhi(w.w); }
__device__ __forceinline__ float wave_sum(float v) {
#pragma unroll
    for (int o = 1; o < 64; o <<= 1) v += __shfl_xor(v, o);
    return v;
}
__device__ const unsigned char T5B[129] = {
    0, 1, 2, 3, 4, 5, 6, 7, 8, 9, 10, 11, 12, 13, 14, 15, 16, 16, 16, 17, 17, 18, 18, 18, 19, 19, 19, 20, 20, 20, 20, 21, 21, 21, 21, 22, 22, 22, 22, 22, 23, 23, 23, 23, 23, 23, 24, 24, 24, 24, 24, 24,
    25, 25, 25, 25, 25, 25, 25, 26, 26, 26, 26, 26, 26, 26, 26, 27, 27, 27, 27, 27, 27, 27, 27, 27, 27, 28, 28, 28, 28, 28, 28, 28, 28, 28, 28, 29, 29, 29, 29, 29, 29, 29, 29, 29, 29, 29, 29,
    30, 30, 30, 30, 30, 30, 30, 30, 30, 30, 30, 30, 30, 30, 31, 31, 31, 31, 31, 31, 31, 31, 31, 31, 31, 31, 31, 31, 31, 31};

struct Args { const float* in[15]; float* out; unsigned char* ws; };
typedef const __attribute__((address_space(4))) Args* KArgs;
__device__ __forceinline__ KArgs kargs() { unsigned long long p = (unsigned long long)__builtin_amdgcn_kernarg_segment_ptr(); asm volatile("" : "+s"(p)); return (KArgs)p; }

struct Ctx { LAS unsigned char* lds; int tid, lane, wave, G, vcu, bid; };
__device__ __forceinline__ Ctx make_ctx(unsigned char* lds) {
    Ctx C; C.lds = (LAS unsigned char*)lds; int t = threadIdx.x; asm volatile("" : "+v"(t)); C.tid = t; C.lane = t & 63; C.wave = __builtin_amdgcn_readfirstlane(t >> 6);
    int g = gridDim.x, bx = blockIdx.x; asm volatile("" : "+s"(g), "+s"(bx)); C.G = g; C.bid = bx; C.vcu = (g % 8 == 0) ? (bx % 8) * (g / 8) + bx / 8 : bx; return C;
}

__device__ __forceinline__ void p0_transpose_item(const float* W, int K, int N, bf16* WT, int rowmap, LAS float* scr, int item, int lane) {
    const int nblk = N / 32, kb = item / nblk, nb = item % nblk, k0 = 64 * kb, n0 = 32 * nb;
    const int r0 = rowmap == 0 ? n0 : (256 * (n0 >> 7) + (n0 & 127) + (rowmap == 2 ? 128 : 0));
#pragma unroll 8
    for (int i = 0; i < 32; ++i) { const int kk = 2 * i + (lane >> 5); scr[kk * 33 + (lane & 31)] = W[(size_t)(k0 + kk) * N + n0 + (lane & 31)]; }
    LDS_WAIT(); asm volatile("" ::: "memory");
    const int c = lane & 7;
#pragma unroll
    for (int j = 0; j < 4; ++j) { const int n = (lane >> 3) + 8 * j; const LAS float* s = scr + (8 * c) * 33 + n;
        v4u o; o.x = pk2(s[0 * 33], s[1 * 33]); o.y = pk2(s[2 * 33], s[3 * 33]); o.z = pk2(s[4 * 33], s[5 * 33]); o.w = pk2(s[6 * 33], s[7 * 33]);
        *(GAS v4u*)(WT + (size_t)(r0 + n) * K + k0 + 8 * c) = o; }
    LDS_WAIT(); asm volatile("" ::: "memory");
}
__device__ __forceinline__ void p0_prologue(const Ctx& C) {
    const KArgs ka = kargs();
    LAS float* scr = (LAS float*)(C.lds + RING_OFF + C.wave * 16384);
    LAS float* cact = (LAS float*)(C.lds + CACT_OFF);
    for (int i = C.tid; i < 2 * D; i += NTHR) { const float v = ka->in[1][i]; cact[i] = v / (1.0f + __expf(-v)); }
    __syncthreads();
    const int gw = C.vcu * NWAVES + C.wave, NGW = C.G * NWAVES;
    { float* modp = (float*)(ka->ws + WS_MODP);
      for (int u = gw; u < DEPTH * 36 * 16; u += NGW) {
        const int l = u / 576, rem = u % 576, cg = rem / 16, kc = rem % 16;
        const float* Wp = ka->in[3] + ((size_t)l * D + kc * 64) * NMOD + cg * 256 + 4 * C.lane;
        f32x4 a0 = {0.f, 0.f, 0.f, 0.f}, a1 = {0.f, 0.f, 0.f, 0.f};
#pragma unroll 8
        for (int k = 0; k < 64; ++k) { const f32x4 w = *(const GAS f32x4*)(Wp + (size_t)k * NMOD); const float c0 = cact[kc * 64 + k], c1 = cact[D + kc * 64 + k]; a0 += w * c0; a1 += w * c1; }
        *(GAS f32x4*)(modp + ((size_t)((l * 16 + kc) * 2 + 0)) * NMOD + cg * 256 + 4 * C.lane) = a0;
        *(GAS f32x4*)(modp + ((size_t)((l * 16 + kc) * 2 + 1)) * NMOD + cg * 256 + 4 * C.lane) = a1;
      } }
    constexpr int I_G = (D / 64) * (FF / 32), I_D = (FF / 64) * (D / 32), I_IN = (D / 64) * (INC / 32), I_OUT = (D / 64) * (D / 32);
    constexpr int I_LAYER = 4 * I_G + 2 * I_D + I_IN + I_OUT;
    for (int it = gw; it < DEPTH * I_LAYER; it += NGW) {
        const int l = it / I_LAYER; int r = it % I_LAYER;
        bf16* wl = (bf16*)(ka->ws + WS_W + (size_t)l * W_LAYER);
        bf16* wgu0 = wl; bf16* wd0 = (bf16*)((unsigned char*)wl + W_GU); bf16* wgu1 = (bf16*)((unsigned char*)wl + W_GU + W_D); bf16* wd1 = (bf16*)((unsigned char*)wl + 2 * W_GU + W_D);
        bf16* win = (bf16*)((unsigned char*)wl + 2 * W_GU + 2 * W_D); bf16* wout = (bf16*)((unsigned char*)wl + 2 * W_GU + 2 * W_D + W_IN);
        const float* g0 = ka->in[7] + (size_t)(l * 2) * D * FF; const float* u0 = ka->in[8] + (size_t)(l * 2) * D * FF; const float* d0 = ka->in[9] + (size_t)(l * 2) * FF * D;
        if (r < I_G) { p0_transpose_item(g0, D, FF, wgu0, 1, scr, r, C.lane); continue; } r -= I_G;
        if (r < I_G) { p0_transpose_item(u0, D, FF, wgu0, 2, scr, r, C.lane); continue; } r -= I_G;
        if (r < I_D) { p0_transpose_item(d0, FF, D, wd0, 0, scr, r, C.lane); continue; } r -= I_D;
        if (r < I_G) { p0_transpose_item(g0 + (size_t)D * FF, D, FF, wgu1, 1, scr, r, C.lane); continue; } r -= I_G;
        if (r < I_G) { p0_transpose_item(u0 + (size_t)D * FF, D, FF, wgu1, 2, scr, r, C.lane); continue; } r -= I_G;
        if (r < I_D) { p0_transpose_item(d0 + (size_t)FF * D, FF, D, wd1, 0, scr, r, C.lane); continue; } r -= I_D;
        if (r < I_IN) { p0_transpose_item(ka->in[10] + (size_t)l * D * INC, D, INC, win, 0, scr, r, C.lane); continue; } r -= I_IN;
        p0_transpose_item(ka->in[12] + (size_t)l * D * D, D, D, wout, 0, scr, r, C.lane);
    }
}
__device__ __forceinline__ void p0_mod_final(const Ctx& C) {
    const KArgs ka = kargs();
    const float* modp = (const float*)(ka->ws + WS_MODP); float* mod = (float*)(ka->ws + WS_MOD);
    for (int gt = C.vcu * NTHR + C.tid; gt < DEPTH * 2 * NMOD; gt += C.G * NTHR) {
        const int l = gt / (2 * NMOD), rem = gt % (2 * NMOD), b = rem / NMOD, n = rem % NMOD;
        float s = ka->in[4][l * NMOD + n];
#pragma unroll
        for (int kc = 0; kc < 16; ++kc) s += modp[((size_t)((l * 16 + kc) * 2 + b)) * NMOD + n];
        mod[gt] = s;
    }
}
__device__ __forceinline__ void load_row(const float* p, int lane, f32x4 (&v)[4]) {
#pragma unroll
    for (int j = 0; j < 4; ++j) v[j] = *(const GAS f32x4*)(p + 4 * lane + 256 * j);
}
__device__ __forceinline__ void norm_mod_store(const f32x4 (&x)[4], const float* g, const float* sc, const float* sh, bf16* xn, int lane) {
    float ss = 0.f;
#pragma unroll
    for (int j = 0; j < 4; ++j) ss += (x[j].x * x[j].x + x[j].y * x[j].y) + (x[j].z * x[j].z + x[j].w * x[j].w);
    const float rstd = 1.0f / sqrtf(wave_sum(ss) * (1.0f / D) + EPS);
#pragma unroll
    for (int j = 0; j < 4; ++j) { const int c = 4 * lane + 256 * j;
        const f32x4 gg = *(const GAS f32x4*)(g + c), s1 = *(const GAS f32x4*)(sc + c), s0 = *(const GAS f32x4*)(sh + c);
        const f32x4 h = x[j] * rstd * gg * (s1 + 1.0f) + s0;
        u32x2 w; w.x = pk2(h.x, h.y); w.y = pk2(h.z, h.w);
        *(GAS u32x2*)(xn + c) = w; }
}
__device__ __forceinline__ void t_pre(const Ctx& C, const float* x, const float* gpre, const float* modl  , int chunk0, bf16* XN) {
    const int gw = C.vcu * NWAVES + C.wave, NGW = C.G * NWAVES;
    for (int m = gw; m < M; m += NGW) { const int b = m >> 13; f32x4 v[4]; load_row(x + (size_t)m * D, C.lane, v);
        const float* mb = modl + (size_t)b * NMOD + chunk0 * D;
        norm_mod_store(v, gpre, mb + D, mb, XN + (size_t)m * D, C.lane); }
}
__device__ __forceinline__ void t_post(const Ctx& C, const float* xsrc, float* xdst, const float* Y, const float* gpost, const float* modl, int chunk0, float coef,
                                       const float* gpre_next, const float* modn, int chunkn, bf16* XN) {
    const int gw = C.vcu * NWAVES + C.wave, NGW = C.G * NWAVES;
    for (int m = gw; m < M; m += NGW) { const int b = m >> 13; f32x4 y[4], x[4]; load_row(Y + (size_t)m * D, C.lane, y); load_row(xsrc + (size_t)m * D, C.lane, x);
        float ss = 0.f;
#pragma unroll
        for (int j = 0; j < 4; ++j) ss += (y[j].x * y[j].x + y[j].y * y[j].y) + (y[j].z * y[j].z + y[j].w * y[j].w);
        const float rstd = 1.0f / sqrtf(wave_sum(ss) * (1.0f / D) + EPS);
        const float* gate = modl + (size_t)b * NMOD + (chunk0 + 2) * D;
#pragma unroll
        for (int j = 0; j < 4; ++j) { const int c = 4 * C.lane + 256 * j;
            const f32x4 gp = *(const GAS f32x4*)(gpost + c), gt = *(const GAS f32x4*)(gate + c);
            x[j] = x[j] + (y[j] * rstd * gp) * gt * coef;
            *(GAS f32x4*)(xdst + (size_t)m * D + c) = x[j]; }
        if (gpre_next) { const float* mb = modn + (size_t)b * NMOD + chunkn * D; norm_mod_store(x, gpre_next, mb + D, mb, XN + (size_t)m * D, C.lane); }
    }
}
__device__ __forceinline__ void t_groupnorm(const Ctx& C, bf16* O, const float* gg) {
    const int gw = C.vcu * NWAVES + C.wave, NGW = C.G * NWAVES;
    for (int m = gw; m < M; m += NGW) { bf16* row = O + (size_t)m * D + 16 * C.lane;
        const v4u w0 = *(const GAS v4u*)row, w1 = *(const GAS v4u*)(row + 8); float f[16];
        { float t[8]; unpack8(w0, t);
#pragma unroll
          for (int i = 0; i < 8; ++i) f[i] = t[i];
          unpack8(w1, t);
#pragma unroll
          for (int i = 0; i < 8; ++i) f[8 + i] = t[i]; }
        float ss = 0.f;
#pragma unroll
        for (int i = 0; i < 16; ++i) ss += f[i] * f[i];
#pragma unroll
        for (int o = 1; o < 32; o <<= 1) ss += __shfl_xor(ss, o);
        const float rstd = 1.0f / sqrtf(ss * (1.0f / 512.0f) + EPS);
        const float* g = gg + 16 * C.lane;
#pragma unroll
        for (int i = 0; i < 16; ++i) f[i] = f[i] * rstd * g[i];
        v4u o0, o1; o0.x = pk2(f[0], f[1]); o0.y = pk2(f[2], f[3]); o0.z = pk2(f[4], f[5]); o0.w = pk2(f[6], f[7]); o1.x = pk2(f[8], f[9]); o1.y = pk2(f[10], f[11]); o1.z = pk2(f[12], f[13]); o1.w = pk2(f[14], f[15]);
        *(GAS v4u*)row = o0; *(GAS v4u*)(row + 8) = o1; }
}
__device__ __forceinline__ void a_kmean(const Ctx& C, const bf16* QKV, float* kmean) {
    const int gw = C.vcu * NWAVES + C.wave, NGW = C.G * NWAVES, r8 = C.lane >> 3, sub = C.lane & 7;
    for (int u = gw; u < 2 * 8 * 32; u += NGW) { const int b = u >> 8, h = (u >> 5) & 7, n = u & 31;
        const bf16* Kp = QKV + ((size_t)b * SEQ + 256 * n + r8) * INC + KB_OFF + h * 64 + sub * 8;
        float acc[8];
#pragma unroll
        for (int i = 0; i < 8; ++i) acc[i] = 0.f;
#pragma unroll 4
        for (int it = 0; it < 32; ++it) { const v4u w = *(const GAS v4u*)(Kp + (size_t)it * 8 * INC); float f[8]; unpack8(w, f);
#pragma unroll
            for (int i = 0; i < 8; ++i) acc[i] += f[i]; }
#pragma unroll
        for (int i = 0; i < 8; ++i) { float v = acc[i]; v += __shfl_xor(v, 8); v += __shfl_xor(v, 16); v += __shfl_xor(v, 32); acc[i] = v * (1.0f / 256.0f); }
        if (r8 == 0) { float* o = kmean + (size_t)u * 64 + sub * 8;
            *(GAS f32x4*)o = (f32x4){acc[0], acc[1], acc[2], acc[3]}; *(GAS f32x4*)(o + 4) = (f32x4){acc[4], acc[5], acc[6], acc[7]}; }
    }
}
struct PairAcc { float m, l, o[8]; };
__device__ __forceinline__ void pair_attend(PairAcc& A, const float (&q)[8], const bf16* Kp, const bf16* Vp, int nk, int dist0, const LAS float* tbl) {
    for (int j = 0; j < nk; ++j) {
        const v4u kw = *(const GAS v4u*)(Kp + (size_t)j * INC); const v4u vw = *(const GAS v4u*)(Vp + (size_t)j * INC);
        float kf[8], vf[8]; unpack8(kw, kf); unpack8(vw, vf);
        float s = 0.f;
#pragma unroll
        for (int i = 0; i < 8; ++i) s += q[i] * kf[i];
        s += __shfl_xor(s, 1); s += __shfl_xor(s, 2); s += __shfl_xor(s, 4);
        const int dist = dist0 - j; s += tbl[dist < 128 ? dist : 128];
        const float mn = fmaxf(A.m, s), sc = __expf(A.m - mn), p = __expf(s - mn);
        A.l = A.l * sc + p;
#pragma unroll
        for (int i = 0; i < 8; ++i) A.o[i] = A.o[i] * sc + p * vf[i];
        A.m = mn;
    }
}
__device__ __forceinline__ void store_o8(bf16* p, const float (&o)[8], float inv) {
    v4u w; w.x = pk2(o[0] * inv, o[1] * inv); w.y = pk2(o[2] * inv, o[3] * inv); w.z = pk2(o[4] * inv, o[5] * inv); w.w = pk2(o[6] * inv, o[7] * inv);
    *(GAS v4u*)p = w;
}
__device__ __forceinline__ void a_attention(const Ctx& C, const bf16* QKV, const float* kmean, const float* rel_bias, const float* sinks, bf16* O) {
    LAS float* tbl = (LAS float*)(C.lds + RING_OFF); LAS float* km = (LAS float*)(C.lds + RING_OFF + 1024); LAS int* selb = (LAS int*)(C.lds + RING_OFF + 1024 + 8192) + C.wave * 64;
    const int gi = C.lane >> 3, sub = C.lane & 7;
    for (int u = C.vcu; u < 2048; u += C.G) {
        __syncthreads();
        if (u < 1024) {
            const int b = u >> 9, h = (u >> 6) & 7, ci = u & 63, cur = ci >> 1;
            if (C.tid <= 128) tbl[C.tid] = rel_bias[T5B[C.tid] * 16 + 8 + h];
            for (int i = C.tid; i < 32 * 64; i += NTHR) km[i] = kmean[(size_t)((b * 8 + h) * 32) * 64 + i];
            __syncthreads();
            const size_t rowb = (size_t)b * SEQ; const int qw0 = ci * 128 + C.wave * 16;
            { const int ql = C.lane >> 2, part = C.lane & 3; const bf16* qp = QKV + (rowb + qw0 + ql) * INC + QB_OFF + h * 64;
              float g[8];
#pragma unroll
              for (int t = 0; t < 8; ++t) g[t] = 0.f;
#pragma unroll
              for (int c = 0; c < 8; ++c) { const v4u w = *(const GAS v4u*)(qp + 8 * c); float qf[8]; unpack8(w, qf);
#pragma unroll
                  for (int t = 0; t < 8; ++t) { const LAS float* kr = km + (part + 4 * t) * 64 + 8 * c;
#pragma unroll
                      for (int i = 0; i < 8; ++i) g[t] += qf[i] * kr[i]; } }
#pragma unroll
              for (int t = 0; t < 8; ++t) if (part + 4 * t >= cur) g[t] = -INFINITY;
#pragma unroll
              for (int r = 0; r < 3; ++r) { float bv = -INFINITY; int bi = 1000;
#pragma unroll
                  for (int t = 0; t < 8; ++t) if (g[t] > bv) { bv = g[t]; bi = part + 4 * t; }
#pragma unroll
                  for (int off = 1; off <= 2; off <<= 1) { const float ov = __shfl_xor(bv, off); const int oi = __shfl_xor(bi, off); if (ov > bv || (ov == bv && oi < bi)) { bv = ov; bi = oi; } }
                  if (part == 0) selb[ql * 4 + r] = (bv > -INFINITY) ? bi : -1;
#pragma unroll
                  for (int t = 0; t < 8; ++t) if (part + 4 * t == bi) g[t] = -INFINITY; } }
            LDS_WAIT(); __syncthreads();
            const int slot = gi & 3;
            for (int qq = 0; qq < 8; ++qq) { const int ql = 2 * qq + (gi >> 2), i = qw0 + ql;
                const bf16* qp = QKV + (rowb + i) * INC + QB_OFF + h * 64 + sub * 8; float q[8]; { const v4u w = *(const GAS v4u*)qp; unpack8(w, q); }
#pragma unroll
                for (int t = 0; t < 8; ++t) q[t] *= 0.125f;
                int n, nk, dist0;
                if (slot < 3) { n = selb[ql * 4 + slot]; nk = n >= 0 ? 256 : 0; if (n < 0) n = 0; dist0 = i - 256 * n; }
                else { n = cur; nk = i - 256 * cur + 1; dist0 = i - 256 * cur; }
                const bf16* Kp = QKV + (rowb + 256 * n) * INC + KB_OFF + h * 64 + sub * 8; const bf16* Vp = Kp + (VB_OFF - KB_OFF);
                PairAcc A; A.m = -INFINITY; A.l = 0.f;
#pragma unroll
                for (int t = 0; t < 8; ++t) A.o[t] = 0.f;
                pair_attend(A, q, Kp, Vp, nk, dist0, tbl);
                float mx = A.m; mx = fmaxf(mx, __shfl_xor(mx, 8)); mx = fmaxf(mx, __shfl_xor(mx, 16));
                const float f = (A.m == -INFINITY) ? 0.f : __expf(A.m - mx);
                float L = A.l * f; L += __shfl_xor(L, 8); L += __shfl_xor(L, 16);
                float o[8];
#pragma unroll
                for (int t = 0; t < 8; ++t) { float v = A.o[t] * f; v += __shfl_xor(v, 8); v += __shfl_xor(v, 16); o[t] = v; }
                if (slot == 0) store_o8(O + (rowb + i) * D + 512 + h * 64 + sub * 8, o, 1.0f / L);
            }
        } else {
            const int v = u - 1024, b = v >> 9, hq = (v >> 6) & 7, ci = v & 63, kvh = hq >> 2;
            if (C.tid <= 128) tbl[C.tid] = rel_bias[T5B[C.tid] * 16 + hq];
            __syncthreads();
            const size_t rowb = (size_t)b * SEQ; const int qw0 = ci * 128 + C.wave * 16; const float sink = sinks[hq];
            for (int qq = 0; qq < 2; ++qq) { const int ql = 8 * qq + gi, i = qw0 + ql;
                const bf16* qp = QKV + (rowb + i) * INC + QA_OFF + hq * 64 + sub * 8; float q[8]; { const v4u w = *(const GAS v4u*)qp; unpack8(w, q); }
#pragma unroll
                for (int t = 0; t < 8; ++t) q[t] *= 0.125f;
                const int klo = i >= 127 ? i - 127 : 0, nk = i - klo + 1, dist0 = i - klo;
                const bf16* Kp = QKV + (rowb + klo) * INC + KA_OFF + kvh * 64 + sub * 8; const bf16* Vp = Kp + (VA_OFF - KA_OFF);
                PairAcc A; A.m = -INFINITY; A.l = 0.f;
#pragma unroll
                for (int t = 0; t < 8; ++t) A.o[t] = 0.f;
                pair_attend(A, q, Kp, Vp, nk, dist0, tbl);
                const float mx = fmaxf(A.m, sink), f = __expf(A.m - mx), L = A.l * f + __expf(sink - mx);
                store_o8(O + (rowb + i) * D + hq * 64 + sub * 8, A.o, f / L);
            }
        }
    }
}

struct LayerW { const bf16 *wgu0, *wd0, *wgu1, *wd1, *win, *wout; };
__device__ __forceinline__ LayerW layer_w(const unsigned char* ws, int l) {
    const unsigned char* wl = ws + WS_W + (size_t)l * W_LAYER; LayerW w;
    w.wgu0 = (const bf16*)wl; w.wd0 = (const bf16*)(wl + W_GU); w.wgu1 = (const bf16*)(wl + W_GU + W_D); w.wd1 = (const bf16*)(wl + 2 * W_GU + W_D);
    w.win = (const bf16*)(wl + 2 * W_GU + 2 * W_D); w.wout = (const bf16*)(wl + 2 * W_GU + 2 * W_D + W_IN); return w;
}
__global__ void __launch_bounds__(NTHR, 2) trunk_fwd(Args args_unused) {
    extern __shared__ __attribute__((aligned(16))) unsigned char lds[];
    { const Ctx C = make_ctx(lds);
    for (int u = C.tid; u < (LDS_BYTES - LDSCTL_OFF) / 4; u += NTHR) ((LAS unsigned*)(C.lds + LDSCTL_OFF))[u] = 0u;
    __syncthreads();
    { const Ctx C = make_ctx(lds); const KArgs ka = kargs(); (void)xcd_barrier_post((unsigned*)((gu32*)(ka->ws + WS_CTL) + CW_BAR), (volatile LAS unsigned*)(C.lds + MISC_OFF) + 8); } }
#define GRID_BAR() do { const KArgs ka_ = kargs(); XcdBarrier b_; b_.bar = (unsigned*)((gu32*)(ka_->ws + WS_CTL) + CW_BAR); b_.x = xb_xcc_id(); b_.st = (volatile LAS unsigned*)((LAS unsigned char*)lds + MISC_OFF) + 8; xcd_barrier(b_); } while (0)
#define WSP(T, off) ((T*)(ka->ws + (off)))

    { const Ctx C = make_ctx(lds); p0_prologue(C); } GRID_BAR();
    { const Ctx C = make_ctx(lds); p0_mod_final(C); } GRID_BAR();
    { const Ctx C = make_ctx(lds); const KArgs ka = kargs(); t_pre(C, ka->in[0], ka->in[5], WSP(const float, WS_MOD), 0, WSP(bf16, WS_XN)); }
    GRID_BAR();

    for (int l = 0; l < DEPTH; ++l) {
        { const Ctx C = make_ctx(lds); const KArgs ka = kargs(); const LayerW w = layer_w(ka->ws, l);
          pg8::Gemm g{WSP(const bf16, WS_XN), w.wgu0, M, NGU, D}; pg8::StaticOrder S; S.init(M, NGU, C.G, C.bid); pg8::EpiSwiGLU E{WSP(bf16, WS_H), FF};
          pg8::gemm_phase<pg8::EpiSwiGLU, pg8::StaticOrder, true, true>(C.lds + RING_OFF, g, S, E); }
        GRID_BAR();
        { const Ctx C = make_ctx(lds); const KArgs ka = kargs(); const LayerW w = layer_w(ka->ws, l);
          pg8::Gemm g{WSP(const bf16, WS_H), w.wd0, M, D, FF}; pg8::StaticOrder S; S.init(M, D, C.G, C.bid); pg8::EpiF32 E{WSP(float, WS_Y), D};
          pg8::gemm_phase<pg8::EpiF32, pg8::StaticOrder, true, true>(C.lds + RING_OFF, g, S, E); }
        GRID_BAR();
        { const Ctx C = make_ctx(lds); const KArgs ka = kargs(); const float* modl = WSP(const float, WS_MOD) + (size_t)l * 2 * NMOD;
          t_post(C, l == 0 ? ka->in[0] : (const float*)ka->out, ka->out, WSP(const float, WS_Y), ka->in[6] + (size_t)(l * 3 + 0) * D, modl, 0, 0.5f, ka->in[5] + (size_t)(l * 3 + 1) * D, modl, 3, WSP(bf16, WS_XN)); }
        GRID_BAR();
        { const Ctx C = make_ctx(lds); const KArgs ka = kargs(); const LayerW w = layer_w(ka->ws, l);
          pg8::Gemm g{WSP(const bf16, WS_XN), w.win, M, INC, D}; pg8::StaticOrder S; S.init(M, INC, C.G, C.bid); pg8::EpiBf16Bias E{WSP(bf16, WS_QKV), INC, ka->in[11] + (size_t)l * INC};
          pg8::gemm_phase<pg8::EpiBf16Bias, pg8::StaticOrder, true, true>(C.lds + RING_OFF, g, S, E); }
        GRID_BAR();
        { const Ctx C = make_ctx(lds); const KArgs ka = kargs(); a_kmean(C, WSP(const bf16, WS_QKV), WSP(float, WS_KMEAN)); }
        GRID_BAR();
        { const Ctx C = make_ctx(lds); const KArgs ka = kargs(); a_attention(C, WSP(const bf16, WS_QKV), WSP(const float, WS_KMEAN), ka->in[2], ka->in[13] + l * 8, WSP(bf16, WS_O)); }
        GRID_BAR();
        { const Ctx C = make_ctx(lds); const KArgs ka = kargs(); t_groupnorm(C, WSP(bf16, WS_O), ka->in[14] + (size_t)l * D); }
        GRID_BAR();
        { const Ctx C = make_ctx(lds); const KArgs ka = kargs(); const LayerW w = layer_w(ka->ws, l);
          pg8::Gemm g{WSP(const bf16, WS_O), w.wout, M, D, D}; pg8::StaticOrder S; S.init(M, D, C.G, C.bid); pg8::EpiF32 E{WSP(float, WS_Y), D};
          pg8::gemm_phase<pg8::EpiF32, pg8::StaticOrder, true, true>(C.lds + RING_OFF, g, S, E); }
        GRID_BAR();
        { const Ctx C = make_ctx(lds); const KArgs ka = kargs(); const float* modl = WSP(const float, WS_MOD) + (size_t)l * 2 * NMOD;
          t_post(C, ka->out, ka->out, WSP(const float, WS_Y), ka->in[6] + (size_t)(l * 3 + 1) * D, modl, 3, 1.0f, ka->in[5] + (size_t)(l * 3 + 2) * D, modl, 6, WSP(bf16, WS_XN)); }
        GRID_BAR();
        { const Ctx C = make_ctx(lds); const KArgs ka = kargs(); const LayerW w = layer_w(ka->ws, l);
          pg8::Gemm g{WSP(const bf16, WS_XN), w.wgu1, M, NGU, D}; pg8::StaticOrder S; S.init(M, NGU, C.G, C.bid); pg8::EpiSwiGLU E{WSP(bf16, WS_H), FF};
          pg8::gemm_phase<pg8::EpiSwiGLU, pg8::StaticOrder, true, true>(C.lds + RING_OFF, g, S, E); }
        GRID_BAR();
        { const Ctx C = make_ctx(lds); const KArgs ka = kargs(); const LayerW w = layer_w(ka->ws, l);
          pg8::Gemm g{WSP(const bf16, WS_H), w.wd1, M, D, FF}; pg8::StaticOrder S; S.init(M, D, C.G, C.bid); pg8::EpiF32 E{WSP(float, WS_Y), D};
          pg8::gemm_phase<pg8::EpiF32, pg8::StaticOrder, true, true>(C.lds + RING_OFF, g, S, E); }
        GRID_BAR();
        { const Ctx C = make_ctx(lds); const KArgs ka = kargs(); const float* modl = WSP(const float, WS_MOD) + (size_t)l * 2 * NMOD;
          t_post(C, ka->out, ka->out, WSP(const float, WS_Y), ka->in[6] + (size_t)(l * 3 + 2) * D, modl, 6, 0.5f, (l + 1 < DEPTH) ? ka->in[5] + (size_t)((l + 1) * 3) * D : nullptr, modl + 2 * NMOD, 0, WSP(bf16, WS_XN)); }
        GRID_BAR();
    }
}

extern "C" void kernel_launch(void* const* d_in, const int* in_sizes, int n_in, void* d_out, int out_size, void* d_ws, size_t ws_size, hipStream_t stream) {
    static int grid = 0;
    if (grid == 0) {
        if (n_in != 15 || in_sizes[0] != M * D || out_size != M * D || ws_size < WS_END) { fprintf(stderr, "kernel_launch: unexpected shapes (n_in %d, in0 %d, out %d, ws %zu)\n", n_in, n_in > 0 ? in_sizes[0] : -1, out_size, ws_size); grid = -1; return; }
        int dev = 0, cus = 0, per_cu = 0;
        if (hipGetDevice(&dev) != hipSuccess || hipDeviceGetAttribute(&cus, hipDeviceAttributeMultiprocessorCount, dev) != hipSuccess) { grid = -1; return; }
        if (hipFuncSetAttribute((const void*)trunk_fwd, hipFuncAttributeMaxDynamicSharedMemorySize, LDS_BYTES) != hipSuccess) { fprintf(stderr, "kernel_launch: hipFuncSetAttribute failed\n"); grid = -1; return; }
        if (hipOccupancyMaxActiveBlocksPerMultiprocessor(&per_cu, (const void*)trunk_fwd, NTHR, LDS_BYTES) != hipSuccess || per_cu < 1) { fprintf(stderr, "kernel_launch: occupancy query reports %d blocks per CU\n", per_cu); }
        (void)hipGetLastError();
        grid = cus;
    }
    if (grid < 0) return;
    if (hipMemsetAsync((char*)d_ws + WS_CTL, 0, CTL_ZERO_BYTES, stream) != hipSuccess) return;
    Args a{};
    for (int i = 0; i < 15; ++i) a.in[i] = (const float*)d_in[i];
    a.out = (float*)d_out; a.ws = (unsigned char*)d_ws;
    hipLaunchKernelGGL(trunk_fwd, dim3(grid), dim3(NTHR), LDS_BYTES, stream, a);
}
```

```cpp
#include <hip/hip_runtime.h>
#include <cstdio>
#include <cstdint>
namespace pg8 {
#define PG8_LAS __attribute__((address_space(3)))
typedef unsigned short bf16_t;
typedef short bf16x8 __attribute__((ext_vector_type(8)));
typedef float f32x4 __attribute__((ext_vector_type(4)));
typedef unsigned u32x4 __attribute__((ext_vector_type(4)));
constexpr int BM = 256, BK = 64, HALF = 128, HTB = HALF * BK * 2  , STAGE_BYTES = 8 * HTB, NXCD = 8, WGM = 8;

__host__ __device__ __forceinline__ int lds_byte(int r, int c) { const int st = (r >> 4) * 2 + (c >> 5), rr = r & 15, cc = c & 31, ob = rr * 64 + cc * 2; return st * 1024 + (ob ^ (((ob >> 9) & 1) << 5)); }
__host__ __device__ __forceinline__ void stage_rc(int b, int& R, int& C) { const int st = b / 1024, sb = b % 1024, swz = sb ^ (((sb >> 9) & 1) << 5); R = (st >> 1) * 16 + swz / 64; C = (st & 1) * 32 + (swz % 64) / 2; }
__host__ __device__ __forceinline__ int perm32(int rho) { const int n = rho >> 4, i = rho & 15; return 8 * (i >> 2) + 4 * n + (i & 3); }

struct Unit { int pm, pn; };
struct Gemm { const bf16_t* A; const bf16_t* Bt; int M, N, K; };

struct StaticOrder {
    int nM, nN, nwg, G, c;
    __host__ __device__ void init(int M, int N, int G_, int c_) { nM = M / BM; nN = N / BM; nwg = nM * nN; G = G_; c = c_; }
    __host__ __device__ bool next(int i, Unit& u) const {
        const long L = (long)i * G + c; if (L >= nwg) return false;
        int wgid = (int)L; { const int q = nwg / NXCD, r = nwg % NXCD, xcd = wgid % NXCD, off = wgid / NXCD; wgid = (xcd < r ? xcd * (q + 1) : r * (q + 1) + (xcd - r) * q) + off; }
        const int nig = WGM * nN, gid = wgid / nig, fm = gid * WGM, gsz = (nM - fm) < WGM ? (nM - fm) : WGM;
        u.pm = fm + ((wgid % nig) % gsz); u.pn = (wgid % nig) / gsz; return true;
    }
    __device__ __forceinline__ void a_ready(const Unit&) const {}
    __device__ __forceinline__ void done(const Unit&) const {}
};

__device__ __forceinline__ unsigned cvt_pk_bf16(float lo, float hi) { unsigned r; asm volatile("v_cvt_pk_bf16_f32 %0, %1, %2" : "=v"(r) : "v"(lo), "v"(hi)); return r; }
typedef float f32x2 __attribute__((ext_vector_type(2)));

struct EpiSwiGLU {
    static constexpr bool PERM = true, AFTER_DRAIN = false;
    bf16_t* H; int ldh;
    __device__ __forceinline__ void operator()(const f32x4 (&acc)[2][2][4][2], const Unit& u, int wr, int wc, int fr, int fq) const {
        const int row0 = u.pm * BM + wr * 64 + fr; const int col0 = u.pn * HALF + wc * 32 + 8 * fq;
#pragma unroll
        for (int ai = 0; ai < 2; ++ai)
#pragma unroll
            for (int m = 0; m < 4; ++m) { bf16_t* rowp = H + (size_t)(row0 + ai * HALF + m * 16) * ldh + col0;
                float h[8];
#pragma unroll
                for (int n = 0; n < 2; ++n)
#pragma unroll
                    for (int j = 0; j < 4; ++j) { const float g = acc[ai][0][m][n][j], up = acc[ai][1][m][n][j];
                        const float sg = __builtin_amdgcn_rcpf(1.0f + __builtin_amdgcn_exp2f(-1.4426950408889634f * g));
                        h[n * 4 + j] = g * sg * up; }
                u32x4 w; w.x = cvt_pk_bf16(h[0], h[1]); w.y = cvt_pk_bf16(h[2], h[3]); w.z = cvt_pk_bf16(h[4], h[5]); w.w = cvt_pk_bf16(h[6], h[7]);
                *(u32x4*)rowp = w; }
    }
};
struct EpiBf16Bias {
    static constexpr bool PERM = true, AFTER_DRAIN = false;
    bf16_t* O; int ldc; const float* bias;
    __device__ __forceinline__ void operator()(const f32x4 (&acc)[2][2][4][2], const Unit& u, int wr, int wc, int fr, int fq) const {
        const int row0 = u.pm * BM + wr * 64 + fr; const int col0 = u.pn * BM + wc * 32 + 8 * fq;
        f32x4 bv[2][2];
#pragma unroll
        for (int bj = 0; bj < 2; ++bj)
#pragma unroll
            for (int n = 0; n < 2; ++n) bv[bj][n] = *(const f32x4*)(bias + col0 + bj * HALF + 4 * n);
#pragma unroll
        for (int ai = 0; ai < 2; ++ai)
#pragma unroll
            for (int m = 0; m < 4; ++m) { bf16_t* rowp = O + (size_t)(row0 + ai * HALF + m * 16) * ldc + col0;
#pragma unroll
                for (int bj = 0; bj < 2; ++bj) { const f32x4 v0 = acc[ai][bj][m][0] + bv[bj][0], v1 = acc[ai][bj][m][1] + bv[bj][1];
                    u32x4 w; w.x = cvt_pk_bf16(v0[0], v0[1]); w.y = cvt_pk_bf16(v0[2], v0[3]); w.z = cvt_pk_bf16(v1[0], v1[1]); w.w = cvt_pk_bf16(v1[2], v1[3]);
                    *(u32x4*)(rowp + bj * HALF) = w; } }
    }
};
struct EpiF32 {
    static constexpr bool PERM = false, AFTER_DRAIN = false;
    float* Y; int ldc;
    __device__ __forceinline__ void operator()(const f32x4 (&acc)[2][2][4][2], const Unit& u, int wr, int wc, int fr, int fq) const {
        const int row0 = u.pm * BM + wr * 64 + fr; const int col0 = u.pn * BM + wc * 32 + 4 * fq;
#pragma unroll
        for (int ai = 0; ai < 2; ++ai)
#pragma unroll
            for (int m = 0; m < 4; ++m) { float* rowp = Y + (size_t)(row0 + ai * HALF + m * 16) * ldc + col0;
#pragma unroll
                for (int bj = 0; bj < 2; ++bj)
#pragma unroll
                    for (int n = 0; n < 2; ++n) *(f32x4*)(rowp + bj * HALF + n * 16) = acc[ai][bj][m][n]; }
    }
};

template <class Epi, class Sched, bool ALIGN_EPI = false, bool SP2 = false>
__device__ __forceinline__ void gemm_phase(PG8_LAS unsigned char* lds, const Gemm g, const Sched& S, const Epi& E) {
    int tid_ = threadIdx.x; asm volatile("" : "+v"(tid_));
    const int tid = tid_, wid = __builtin_amdgcn_readfirstlane(tid >> 6), lane = tid & 63, wr = wid >> 2, wc = wid & 3, fr = lane & 15, fq = lane >> 4;
    const int K = g.K, nt = K / BK;
    unsigned voffA[2], voffB[2];
#pragma unroll
    for (int i = 0; i < 2; ++i) { int R, C; stage_rc(tid * 16 + i * 8192, R, C); const int Rb = Epi::PERM ? ((R & ~31) + perm32(R & 31)) : R;
        voffA[i] = (unsigned)(R * K + C) * 2u; voffB[i] = (unsigned)(Rb * K + C) * 2u; }
    const size_t kstep = (size_t)(BK * 2);
    const size_t hstep = (size_t)HALF * K * 2;
    const size_t tstep = 2 * hstep;
    const unsigned ldsw = (unsigned)wid * 1024u;
    const int aoff = lds_byte(wr * 64 + fr, fq * 8), boff = lds_byte(wc * 32 + fr, fq * 8);
#define PG8_SA(b, h) (((b) * 2 + (h)) * HTB)
#define PG8_SB(b, h) ((4 + (b) * 2 + (h)) * HTB)
#define PG8_STAGE(bufoff, gbase, voff) do { _Pragma("unroll") for (int _i = 0; _i < 2; ++_i) \
        __builtin_amdgcn_global_load_lds((const unsigned*)((const char*)(gbase) + (voff)[_i]), (PG8_LAS unsigned*)(lds + (bufoff) + ldsw + _i * 8192), 16, 0, 0); } while (0)
#define PG8_LDA(dst, b, h) do { _Pragma("unroll") for (int m = 0; m < 4; ++m) _Pragma("unroll") for (int k = 0; k < 2; ++k) dst[m][k] = *(const PG8_LAS bf16x8*)(lds + PG8_SA(b, h) + aoff + m * 2048 + k * 1024); } while (0)
#define PG8_LDB(dst, b, h) do { _Pragma("unroll") for (int n = 0; n < 2; ++n) _Pragma("unroll") for (int k = 0; k < 2; ++k) dst[n][k] = *(const PG8_LAS bf16x8*)(lds + PG8_SB(b, h) + boff + n * 2048 + k * 1024); } while (0)
#define PG8_MMA(ai, bj, At, Bt) do { __builtin_amdgcn_s_setprio(1); _Pragma("unroll") for (int m = 0; m < 4; ++m) _Pragma("unroll") for (int n = 0; n < 2; ++n) _Pragma("unroll") for (int k = 0; k < 2; ++k) \
        acc[ai][bj][m][n] = __builtin_amdgcn_mfma_f32_16x16x32_bf16(Bt[n][k], At[m][k], acc[ai][bj][m][n], 0, 0, 0); __builtin_amdgcn_s_setprio(0); } while (0)
#define PG8_WAIT_V(n) asm volatile("s_waitcnt vmcnt(" #n ")" ::: "memory")
#define PG8_WAIT_L(n) asm volatile("s_waitcnt lgkmcnt(" #n ")" ::: "memory")
#define PG8_BAR __builtin_amdgcn_s_barrier()
#define PG8_SCHED __builtin_amdgcn_sched_barrier(0)
    Unit cur, nxt; int ui = 0;
    if (!S.next(0, cur)) return;
    f32x4 acc[2][2][4][2];
#pragma unroll
    for (int a = 0; a < 2; ++a)
#pragma unroll
        for (int b = 0; b < 2; ++b)
#pragma unroll
            for (int m = 0; m < 4; ++m)
#pragma unroll
                for (int n = 0; n < 2; ++n) acc[a][b][m][n] = (f32x4){0.f, 0.f, 0.f, 0.f};
    bf16x8 At[4][2], B0[2][2], B1[2][2];
    const char* cA = (const char*)g.A + (size_t)cur.pm * tstep; const char* cB = (const char*)g.Bt + (size_t)cur.pn * tstep;
    S.a_ready(cur);
    if constexpr (SP2) {
        PG8_STAGE(PG8_SB(0, 0), cB, voffB); PG8_STAGE(PG8_SB(0, 1), cB + hstep, voffB); PG8_STAGE(PG8_SA(0, 0), cA, voffA); PG8_STAGE(PG8_SA(0, 1), cA + hstep, voffA);
        if (wr == 1) PG8_BAR;
        PG8_WAIT_V(2); PG8_BAR;
        PG8_STAGE(PG8_SB(1, 0), cB + kstep, voffB); PG8_STAGE(PG8_SA(1, 0), cA + kstep, voffA); PG8_STAGE(PG8_SB(1, 1), cB + hstep + kstep, voffB);
        PG8_WAIT_V(6); PG8_BAR;
    } else {
        PG8_STAGE(PG8_SB(0, 0), cB, voffB); PG8_STAGE(PG8_SA(0, 0), cA, voffA); PG8_STAGE(PG8_SB(0, 1), cB + hstep, voffB); PG8_STAGE(PG8_SA(0, 1), cA + hstep, voffA);
        if (wr == 1) PG8_BAR;
        PG8_WAIT_V(4); PG8_BAR;
        PG8_STAGE(PG8_SB(1, 0), cB + kstep, voffB); PG8_STAGE(PG8_SA(1, 0), cA + kstep, voffA); PG8_STAGE(PG8_SB(1, 1), cB + hstep + kstep, voffB);
        PG8_WAIT_V(6); PG8_BAR;
    }
    for (;;) {
        const bool has_next = S.next(ui + 1, nxt);
        const char* nA = has_next ? (const char*)g.A + (size_t)nxt.pm * tstep : cA; const char* nB = has_next ? (const char*)g.Bt + (size_t)nxt.pn * tstep : cB;
        for (int t = 0; t < nt; t += 2) {
            const bool last = (t == nt - 2);
            const char* a1 = cA + (size_t)(t + 1) * kstep;
            const char* a2 = last ? nA : cA + (size_t)(t + 2) * kstep; const char* b2 = last ? nB : cB + (size_t)(t + 2) * kstep;
            const char* a3 = a2 + kstep; const char* b3 = b2 + kstep;
            if (last && has_next) S.a_ready(nxt);
            if constexpr (SP2) {
            PG8_LDB(B0, 0, 0); PG8_LDB(B1, 0, 1); PG8_SCHED; PG8_LDA(At, 0, 0); PG8_STAGE(PG8_SA(1, 1), a1 + hstep, voffA);
            PG8_WAIT_V(8); PG8_WAIT_L(0); PG8_BAR; PG8_MMA(0, 0, At, B0); PG8_MMA(0, 1, At, B1); PG8_BAR; PG8_SCHED;
            PG8_LDA(At, 0, 1); PG8_STAGE(PG8_SB(0, 0), b2, voffB); PG8_STAGE(PG8_SB(0, 1), b2 + hstep, voffB); PG8_STAGE(PG8_SA(0, 0), a2, voffA);
            PG8_WAIT_V(8); PG8_WAIT_L(0); PG8_BAR; PG8_MMA(1, 0, At, B0); PG8_MMA(1, 1, At, B1); PG8_BAR; PG8_SCHED;
            PG8_LDB(B0, 1, 0); PG8_LDB(B1, 1, 1); PG8_SCHED; PG8_LDA(At, 1, 0); PG8_STAGE(PG8_SA(0, 1), a2 + hstep, voffA);
            PG8_WAIT_V(8); PG8_WAIT_L(0); PG8_BAR; PG8_MMA(0, 0, At, B0); PG8_MMA(0, 1, At, B1); PG8_BAR; PG8_SCHED;
            PG8_LDA(At, 1, 1); PG8_STAGE(PG8_SB(1, 0), b3, voffB); PG8_STAGE(PG8_SB(1, 1), b3 + hstep, voffB); PG8_STAGE(PG8_SA(1, 0), a3, voffA);
            PG8_WAIT_V(8); PG8_WAIT_L(0); PG8_BAR; PG8_MMA(1, 0, At, B0); PG8_MMA(1, 1, At, B1); PG8_BAR; PG8_SCHED;
            } else {
            PG8_LDB(B0, 0, 0); PG8_SCHED; PG8_LDA(At, 0, 0); PG8_STAGE(PG8_SA(1, 1), a1 + hstep, voffA);
            PG8_WAIT_L(8); PG8_BAR; PG8_WAIT_L(0); PG8_MMA(0, 0, At, B0); PG8_BAR; PG8_SCHED;
            PG8_LDB(B1, 0, 1); PG8_STAGE(PG8_SB(0, 0), b2, voffB);
            PG8_BAR; PG8_WAIT_L(0); PG8_MMA(0, 1, At, B1); PG8_BAR;
            PG8_LDA(At, 0, 1); PG8_STAGE(PG8_SA(0, 0), a2, voffA);
            PG8_BAR; PG8_WAIT_L(0); PG8_MMA(1, 0, At, B0); PG8_BAR; PG8_SCHED;
            PG8_STAGE(PG8_SB(0, 1), b2 + hstep, voffB);
            PG8_WAIT_V(6); PG8_BAR; PG8_MMA(1, 1, At, B1); PG8_BAR;
            PG8_LDB(B0, 1, 0); PG8_SCHED; PG8_LDA(At, 1, 0); PG8_STAGE(PG8_SA(0, 1), a2 + hstep, voffA);
            PG8_WAIT_L(8); PG8_BAR; PG8_WAIT_L(0); PG8_MMA(0, 0, At, B0); PG8_BAR; PG8_SCHED;
            PG8_LDB(B1, 1, 1); PG8_STAGE(PG8_SB(1, 0), b3, voffB);
            PG8_BAR; PG8_WAIT_L(0); PG8_MMA(0, 1, At, B1); PG8_BAR;
            PG8_LDA(At, 1, 1); PG8_STAGE(PG8_SA(1, 0), a3, voffA);
            PG8_BAR; PG8_WAIT_L(0); PG8_MMA(1, 0, At, B0); PG8_BAR; PG8_SCHED;
            PG8_STAGE(PG8_SB(1, 1), b3 + hstep, voffB);
            PG8_WAIT_V(6); PG8_BAR; PG8_MMA(1, 1, At, B1); PG8_BAR;
            }
        }
        if constexpr (ALIGN_EPI) { if (wr == 0) PG8_BAR; }
        if constexpr (!Epi::AFTER_DRAIN) { E(acc, cur, wr, wc, fr, fq); S.done(cur); }
        if (!has_next) break;
#pragma unroll
        for (int a = 0; a < 2; ++a)
#pragma unroll
            for (int b = 0; b < 2; ++b)
#pragma unroll
                for (int m = 0; m < 4; ++m)
#pragma unroll
                    for (int n = 0; n < 2; ++n) acc[a][b][m][n] = (f32x4){0.f, 0.f, 0.f, 0.f};
        cur = nxt; cA = nA; cB = nB; ++ui;
        if constexpr (ALIGN_EPI) { if (wr == 1) PG8_BAR; }
    }
    PG8_WAIT_V(0);
    if constexpr (!ALIGN_EPI) { if (wr == 0) PG8_BAR; }
    PG8_BAR;
    if constexpr (Epi::AFTER_DRAIN) { E.fused(acc, cur, wr, wc, fr, fq, lds, wid, lane); S.done(cur); }
#undef PG8_SA
#undef PG8_SB
#undef PG8_STAGE
#undef PG8_LDA
#undef PG8_LDB
#undef PG8_MMA
#undef PG8_WAIT_V
#undef PG8_WAIT_L
#undef PG8_BAR
#undef PG8_SCHED
}
}
#define GAS __attribute__((address_space(1)))
#define LAS __attribute__((address_space(3)))
typedef unsigned short bf16;
typedef unsigned v4u __attribute__((ext_vector_type(4)));
typedef float f32x4 __attribute__((ext_vector_type(4)));
typedef short bf16x8 __attribute__((ext_vector_type(8)));
typedef GAS unsigned gu32;
typedef GAS unsigned long long gu64;
#define RLX_AGENT __ATOMIC_RELAXED, __HIP_MEMORY_SCOPE_AGENT
#define LDS_WAIT() asm volatile("s_waitcnt lgkmcnt(0)" ::: "memory")
#define VM_WAIT() asm volatile("s_waitcnt vmcnt(0)" ::: "memory")
__device__ __forceinline__ unsigned long long rt() { return __builtin_amdgcn_s_memrealtime(); }
__device__ __forceinline__ unsigned f2bf(float f) { unsigned u = __builtin_bit_cast(unsigned, f); return (u + 0x7fffu + ((u >> 16) & 1u)) >> 16; }
__device__ __forceinline__ unsigned pk2(float lo, float hi) { return f2bf(lo) | (f2bf(hi) << 16); }

#define XB_TMO      128
#define XB_XCNT(j)  (256  + 64 * (j))
#define XB_XSUB(j)  (1280 + 64 * (j))
#define XB_XGEN(j)  (2304 + 64 * (j))
#define XB_TOP      3328
#define XB_TOPGEN   3392
#define XCD_BAR_WORDS 3456
#define XB_SPIN_CAP (1u << 18)

__device__ __forceinline__ unsigned xb_ld(unsigned* p)              { return __hip_atomic_load(p, __ATOMIC_RELAXED, __HIP_MEMORY_SCOPE_AGENT); }
__device__ __forceinline__ unsigned xb_add(unsigned* p, unsigned v) { return __hip_atomic_fetch_add(p, v, __ATOMIC_RELAXED, __HIP_MEMORY_SCOPE_AGENT); }
__device__ __forceinline__ unsigned xb_xcc_id() { return (unsigned)__builtin_amdgcn_s_getreg((3 << 11) | 20) & 0xFu; }
#define XB_SPIN(cond, bar) do { unsigned _sp = 0; while (cond) { __builtin_amdgcn_s_sleep(1); \
    if ((++_sp & 255u) == 0u) { if (xb_ld(&(bar)[XB_TMO])) break; if (_sp > XB_SPIN_CAP) { atomicAdd(&(bar)[XB_TMO], 1u); break; } } } } while (0)

struct XcdBarrier {
    unsigned* bar; unsigned x;
    volatile LAS unsigned* st;
};

__device__ __forceinline__ XcdBarrier xcd_barrier_post(unsigned* bar, volatile LAS unsigned* st) {
    XcdBarrier b; b.bar = bar; b.x = xb_xcc_id(); b.st = st;
    if (threadIdx.x == 0) (void)xb_add(&bar[XB_XCNT(b.x)], 1u);
    return b;
}
__device__ __forceinline__ void xcd_barrier_complete(unsigned* bar, unsigned x, unsigned& nloc, unsigned& nx) {
    const unsigned G = gridDim.x * gridDim.y * gridDim.z;
    unsigned sum, cnt, mine, sp = 0u;
    for (;;) {
        sum = 0u; cnt = 0u; mine = 0u;
#pragma unroll
        for (unsigned j = 0; j < 16; ++j) { const unsigned c = xb_ld(&bar[XB_XCNT(j)]); sum += c; cnt += (c > 0u) ? 1u : 0u; mine = (j == x) ? c : mine; }
        if (sum == G) break;
        __builtin_amdgcn_s_sleep(1);
        if ((++sp & 255u) == 0u) { if (xb_ld(&bar[XB_TMO])) break; if (sp > XB_SPIN_CAP) { atomicAdd(&bar[XB_TMO], 1u); break; } }
    }
    nloc = mine > 0u ? mine : 1u; nx = cnt > 0u ? cnt : 1u;
}

__device__ __forceinline__ void xcd_barrier(const XcdBarrier& b) {
    asm volatile("s_waitcnt vmcnt(0)" ::: "memory");
    __syncthreads();
    if (threadIdx.x == 0) {
        unsigned* bar = b.bar;
        __builtin_amdgcn_s_waitcnt(0);
        unsigned nloc = b.st[0], nx = b.st[1];
        if (nloc == 0u) { xcd_barrier_complete(bar, b.x, nloc, nx); b.st[0] = nloc; b.st[1] = nx; }
        const unsigned old = xb_add(&bar[XB_XSUB(b.x)], 1u);
        const unsigned gen = old / nloc;
        if (old + 1u == (gen + 1u) * nloc) {
            __builtin_amdgcn_fence(__ATOMIC_RELEASE, "agent");
            asm volatile("s_waitcnt vmcnt(0)" ::: "memory");
            const unsigned og = xb_add(&bar[XB_TOP], 1u);
            const unsigned tg = og / nx;
            if (og + 1u == (tg + 1u) * nx) xb_add(&bar[XB_TOPGEN], 1u);
            else XB_SPIN(xb_ld(&bar[XB_TOPGEN]) == tg, bar);
            __builtin_amdgcn_fence(__ATOMIC_ACQUIRE, "agent");
            xb_add(&bar[XB_XGEN(b.x)], 1u);
            asm volatile("s_waitcnt vmcnt(0)" ::: "memory");
        } else {
            XB_SPIN(xb_ld(&bar[XB_XGEN(b.x)]) == gen, bar);
            __builtin_amdgcn_fence(__ATOMIC_ACQUIRE, "agent");
            asm volatile("s_waitcnt vmcnt(0)" ::: "memory");
        }
    }
    __syncthreads();
}

constexpr int NWAVES = 8, NTHR = NWAVES * 64;
constexpr int BATCH = 2, SEQ = 8192, D = 1024, M = BATCH * SEQ, DEPTH = 4, FF = 2816, NGU = 2 * FF, INC = 2304, NMOD = 9 * D;
constexpr int QA_OFF = 0, KA_OFF = 512, VA_OFF = 640, QB_OFF = 768, KB_OFF = 1280, VB_OFF = 1792;
constexpr float EPS = 1e-6f;
constexpr size_t MiB = 1u << 20;
constexpr size_t WS_CTL = 0, CTL_ZERO_BYTES = 1 * MiB;
constexpr size_t WS_MODP = 2 * MiB;
constexpr size_t WS_MOD = 8 * MiB;
constexpr size_t WS_KMEAN = 9 * MiB;
constexpr size_t WS_W = 16 * MiB;
constexpr size_t W_GU = (size_t)NGU * D * 2, W_D = (size_t)D * FF * 2, W_IN = (size_t)INC * D * 2, W_OUT = (size_t)D * D * 2;
constexpr size_t W_LAYER = 2 * W_GU + 2 * W_D + W_IN + W_OUT;
constexpr size_t WS_XN = 176 * MiB;
constexpr size_t WS_H = 208 * MiB;
constexpr size_t WS_Y = 296 * MiB;
constexpr size_t WS_QKV = 360 * MiB;
constexpr size_t WS_O = 432 * MiB;
constexpr size_t WS_END = 464 * MiB;
constexpr size_t WS_PO = 208 * MiB, WS_PML = 336 * MiB, WS_SEL = 340 * MiB;
static_assert(WS_PO == WS_H && WS_SEL + (size_t)16 * SEQ * 4 <= WS_QKV, "attention scratch overlay");
static_assert(WS_W + DEPTH * W_LAYER <= WS_XN && WS_H + (size_t)M * FF * 2 <= WS_Y && WS_QKV + (size_t)M * INC * 2 <= WS_O, "d_ws map");
constexpr int CW_BAR = 4096;
constexpr int RING_OFF = 0, RING_BYTES = 131072;
constexpr int LDSCTL_OFF = RING_BYTES, MISC_OFF = LDSCTL_OFF + 320;
constexpr int CACT_OFF = RING_BYTES + 1024;
constexpr int LDS_BYTES = 147456;
static_assert(CACT_OFF + 8192 <= LDS_BYTES, "LDS map");

typedef unsigned long long u64;
typedef unsigned u32x2 __attribute__((ext_vector_type(2)));
__device__ __forceinline__ float bflo(unsigned w) { return __uint_as_float(w << 16); }
__device__ __forceinline__ float bfhi(unsigned w) { return __uint_as_float(w & 0xffff0000u); }
__device__ __forceinline__ void unpack8(const v4u w, float (&f)[8]) { f[0] = bflo(w.x); f[1] = bfhi(w.x); f[2] = bflo(w.y); f[3] = bfhi(w.y); f[4] = bflo(w.z); f[5] = bfhi(w.z); f[6] = bflo(w.w); f[7] = bfhi(w.w); }
__device__ __forceinline__ float wave_sum(float v) {
#pragma unroll
    for (int o = 1; o < 64; o <<= 1) v += __shfl_xor(v, o);
    return v;
}
__device__ const unsigned char T5B[129] = {
    0, 1, 2, 3, 4, 5, 6, 7, 8, 9, 10, 11, 12, 13, 14, 15, 16, 16, 16, 17, 17, 18, 18, 18, 19, 19, 19, 20, 20, 20, 20, 21, 21, 21, 21, 22, 22, 22, 22, 22, 23, 23, 23, 23, 23, 23, 24, 24, 24, 24, 24, 24,
    25, 25, 25, 25, 25, 25, 25, 26, 26, 26, 26, 26, 26, 26, 26, 27, 27, 27, 27, 27, 27, 27, 27, 27, 27, 28, 28, 28, 28, 28, 28, 28, 28, 28, 28, 29, 29, 29, 29, 29, 29, 29, 29, 29, 29, 29, 29,
    30, 30, 30, 30, 30, 30, 30, 30, 30, 30, 30, 30, 30, 30, 31, 31, 31, 31, 31, 31, 31, 31, 31, 31, 31, 31, 31, 31, 31, 31};

struct Args { const float* in[15]; float* out; unsigned char* ws; };
typedef const __attribute__((address_space(4))) Args* KArgs;
__device__ __forceinline__ KArgs kargs() { unsigned long long p = (unsigned long long)__builtin_amdgcn_kernarg_segment_ptr(); asm volatile("" : "+s"(p)); return (KArgs)p; }

struct Ctx { LAS unsigned char* lds; int tid, lane, wave, G, vcu, bid; };
__device__ __forceinline__ Ctx make_ctx(unsigned char* lds) {
    Ctx C; C.lds = (LAS unsigned char*)lds; int t = threadIdx.x; asm volatile("" : "+v"(t)); C.tid = t; C.lane = t & 63; C.wave = __builtin_amdgcn_readfirstlane(t >> 6);
    int g = gridDim.x, bx = blockIdx.x; asm volatile("" : "+s"(g), "+s"(bx)); C.G = g; C.bid = bx; C.vcu = (g % 8 == 0) ? (bx % 8) * (g / 8) + bx / 8 : bx; return C;
}

__device__ __forceinline__ void p0_transpose_item(const float* W, int K, int N, bf16* WT, int rowmap, LAS float* scr, int item, int lane) {
    const int nblk = N / 32, kb = item / nblk, nb = item % nblk, k0 = 64 * kb, n0 = 32 * nb;
    const int r0 = rowmap == 0 ? n0 : (256 * (n0 >> 7) + (n0 & 127) + (rowmap == 2 ? 128 : 0));
#pragma unroll 8
    for (int i = 0; i < 32; ++i) { const int kk = 2 * i + (lane >> 5); scr[kk * 33 + (lane & 31)] = W[(size_t)(k0 + kk) * N + n0 + (lane & 31)]; }
    LDS_WAIT(); asm volatile("" ::: "memory");
    const int c = lane & 7;
#pragma unroll
    for (int j = 0; j < 4; ++j) { const int n = (lane >> 3) + 8 * j; const LAS float* s = scr + (8 * c) * 33 + n;
        v4u o; o.x = pk2(s[0 * 33], s[1 * 33]); o.y = pk2(s[2 * 33], s[3 * 33]); o.z = pk2(s[4 * 33], s[5 * 33]); o.w = pk2(s[6 * 33], s[7 * 33]);
        *(GAS v4u*)(WT + (size_t)(r0 + n) * K + k0 + 8 * c) = o; }
    LDS_WAIT(); asm volatile("" ::: "memory");
}
__device__ __forceinline__ void p0_prologue(const Ctx& C) {
    const KArgs ka = kargs();
    LAS float* scr = (LAS float*)(C.lds + RING_OFF + C.wave * 16384);
    LAS float* cact = (LAS float*)(C.lds + CACT_OFF);
    for (int i = C.tid; i < 2 * D; i += NTHR) { const float v = ka->in[1][i]; cact[i] = v / (1.0f + __expf(-v)); }
    __syncthreads();
    const int gw = C.vcu * NWAVES + C.wave, NGW = C.G * NWAVES;
    { float* modp = (float*)(ka->ws + WS_MODP);
      for (int u = gw; u < DEPTH * 36 * 16; u += NGW) {
        const int l = u / 576, rem = u % 576, cg = rem / 16, kc = rem % 16;
        const float* Wp = ka->in[3] + ((size_t)l * D + kc * 64) * NMOD + cg * 256 + 4 * C.lane;
        f32x4 a0 = {0.f, 0.f, 0.f, 0.f}, a1 = {0.f, 0.f, 0.f, 0.f};
#pragma unroll 8
        for (int k = 0; k < 64; ++k) { const f32x4 w = *(const GAS f32x4*)(Wp + (size_t)k * NMOD); const float c0 = cact[kc * 64 + k], c1 = cact[D + kc * 64 + k]; a0 += w * c0; a1 += w * c1; }
        *(GAS f32x4*)(modp + ((size_t)((l * 16 + kc) * 2 + 0)) * NMOD + cg * 256 + 4 * C.lane) = a0;
        *(GAS f32x4*)(modp + ((size_t)((l * 16 + kc) * 2 + 1)) * NMOD + cg * 256 + 4 * C.lane) = a1;
      } }
    constexpr int I_G = (D / 64) * (FF / 32), I_D = (FF / 64) * (D / 32), I_IN = (D / 64) * (INC / 32), I_OUT = (D / 64) * (D / 32);
    constexpr int I_LAYER = 4 * I_G + 2 * I_D + I_IN + I_OUT;
    for (int it = gw; it < DEPTH * I_LAYER; it += NGW) {
        const int l = it / I_LAYER; int r = it % I_LAYER;
        bf16* wl = (bf16*)(ka->ws + WS_W + (size_t)l * W_LAYER);
        bf16* wgu0 = wl; bf16* wd0 = (bf16*)((unsigned char*)wl + W_GU); bf16* wgu1 = (bf16*)((unsigned char*)wl + W_GU + W_D); bf16* wd1 = (bf16*)((unsigned char*)wl + 2 * W_GU + W_D);
        bf16* win = (bf16*)((unsigned char*)wl + 2 * W_GU + 2 * W_D); bf16* wout = (bf16*)((unsigned char*)wl + 2 * W_GU + 2 * W_D + W_IN);
        const float* g0 = ka->in[7] + (size_t)(l * 2) * D * FF; const float* u0 = ka->in[8] + (size_t)(l * 2) * D * FF; const float* d0 = ka->in[9] + (size_t)(l * 2) * FF * D;
        if (r < I_G) { p0_transpose_item(g0, D, FF, wgu0, 1, scr, r, C.lane); continue; } r -= I_G;
        if (r < I_G) { p0_transpose_item(u0, D, FF, wgu0, 2, scr, r, C.lane); continue; } r -= I_G;
        if (r < I_D) { p0_transpose_item(d0, FF, D, wd0, 0, scr, r, C.lane); continue; } r -= I_D;
        if (r < I_G) { p0_transpose_item(g0 + (size_t)D * FF, D, FF, wgu1, 1, scr, r, C.lane); continue; } r -= I_G;
        if (r < I_G) { p0_transpose_item(u0 + (size_t)D * FF, D, FF, wgu1, 2, scr, r, C.lane); continue; } r -= I_G;
        if (r < I_D) { p0_transpose_item(d0 + (size_t)FF * D, FF, D, wd1, 0, scr, r, C.lane); continue; } r -= I_D;
        if (r < I_IN) { p0_transpose_item(ka->in[10] + (size_t)l * D * INC, D, INC, win, 0, scr, r, C.lane); continue; } r -= I_IN;
        p0_transpose_item(ka->in[12] + (size_t)l * D * D, D, D, wout, 0, scr, r, C.lane);
    }
}
__device__ __forceinline__ void p0_mod_final(const Ctx& C) {
    const KArgs ka = kargs();
    const float* modp = (const float*)(ka->ws + WS_MODP); float* mod = (float*)(ka->ws + WS_MOD);
    for (int gt = C.vcu * NTHR + C.tid; gt < DEPTH * 2 * NMOD; gt += C.G * NTHR) {
        const int l = gt / (2 * NMOD), rem = gt % (2 * NMOD), b = rem / NMOD, n = rem % NMOD;
        float s = ka->in[4][l * NMOD + n];
#pragma unroll
        for (int kc = 0; kc < 16; ++kc) s += modp[((size_t)((l * 16 + kc) * 2 + b)) * NMOD + n];
        mod[gt] = s;
    }
}
__device__ __forceinline__ void load_row(const float* p, int lane, f32x4 (&v)[4]) {
#pragma unroll
    for (int j = 0; j < 4; ++j) v[j] = *(const GAS f32x4*)(p + 4 * lane + 256 * j);
}
__device__ __forceinline__ void norm_mod_store(const f32x4 (&x)[4], const float* g, const float* sc, const float* sh, bf16* xn, int lane) {
    float ss = 0.f;
#pragma unroll
    for (int j = 0; j < 4; ++j) ss += (x[j].x * x[j].x + x[j].y * x[j].y) + (x[j].z * x[j].z + x[j].w * x[j].w);
    const float rstd = 1.0f / sqrtf(wave_sum(ss) * (1.0f / D) + EPS);
#pragma unroll
    for (int j = 0; j < 4; ++j) { const int c = 4 * lane + 256 * j;
        const f32x4 gg = *(const GAS f32x4*)(g + c), s1 = *(const GAS f32x4*)(sc + c), s0 = *(const GAS f32x4*)(sh + c);
        const f32x4 h = x[j] * rstd * gg * (s1 + 1.0f) + s0;
        u32x2 w; w.x = pk2(h.x, h.y); w.y = pk2(h.z, h.w);
        *(GAS u32x2*)(xn + c) = w; }
}
__device__ __forceinline__ void t_pre(const Ctx& C, const float* x, const float* gpre, const float* modl  , int chunk0, bf16* XN) {
    const int gw = C.vcu * NWAVES + C.wave, NGW = C.G * NWAVES;
    for (int m = gw; m < M; m += NGW) { const int b = m >> 13; f32x4 v[4]; load_row(x + (size_t)m * D, C.lane, v);
        const float* mb = modl + (size_t)b * NMOD + chunk0 * D;
        norm_mod_store(v, gpre, mb + D, mb, XN + (size_t)m * D, C.lane); }
}
__device__ __forceinline__ void t_post(const Ctx& C, const float* xsrc, float* xdst, const float* Y, const float* gpost, const float* modl, int chunk0, float coef,
                                       const float* gpre_next, const float* modn, int chunkn, bf16* XN) {
    const int gw = C.vcu * NWAVES + C.wave, NGW = C.G * NWAVES;
    for (int m = gw; m < M; m += NGW) { const int b = m >> 13; f32x4 y[4], x[4]; load_row(Y + (size_t)m * D, C.lane, y); load_row(xsrc + (size_t)m * D, C.lane, x);
        float ss = 0.f;
#pragma unroll
        for (int j = 0; j < 4; ++j) ss += (y[j].x * y[j].x + y[j].y * y[j].y) + (y[j].z * y[j].z + y[j].w * y[j].w);
        const float rstd = 1.0f / sqrtf(wave_sum(ss) * (1.0f / D) + EPS);
        const float* gate = modl + (size_t)b * NMOD + (chunk0 + 2) * D;
#pragma unroll
        for (int j = 0; j < 4; ++j) { const int c = 4 * C.lane + 256 * j;
            const f32x4 gp = *(const GAS f32x4*)(gpost + c), gt = *(const GAS f32x4*)(gate + c);
            x[j] = x[j] + (y[j] * rstd * gp) * gt * coef;
            *(GAS f32x4*)(xdst + (size_t)m * D + c) = x[j]; }
        if (gpre_next) { const float* mb = modn + (size_t)b * NMOD + chunkn * D; norm_mod_store(x, gpre_next, mb + D, mb, XN + (size_t)m * D, C.lane); }
    }
}
__device__ __forceinline__ void t_groupnorm(const Ctx& C, bf16* O, const float* gg) {
    const int gw = C.vcu * NWAVES + C.wave, NGW = C.G * NWAVES;
    for (int m = gw; m < M; m += NGW) { bf16* row = O + (size_t)m * D + 16 * C.lane;
        const v4u w0 = *(const GAS v4u*)row, w1 = *(const GAS v4u*)(row + 8); float f[16];
        { float t[8]; unpack8(w0, t);
#pragma unroll
          for (int i = 0; i < 8; ++i) f[i] = t[i];
          unpack8(w1, t);
#pragma unroll
          for (int i = 0; i < 8; ++i) f[8 + i] = t[i]; }
        float ss = 0.f;
#pragma unroll
        for (int i = 0; i < 16; ++i) ss += f[i] * f[i];
#pragma unroll
        for (int o = 1; o < 32; o <<= 1) ss += __shfl_xor(ss, o);
        const float rstd = 1.0f / sqrtf(ss * (1.0f / 512.0f) + EPS);
        const float* g = gg + 16 * C.lane;
#pragma unroll
        for (int i = 0; i < 16; ++i) f[i] = f[i] * rstd * g[i];
        v4u o0, o1; o0.x = pk2(f[0], f[1]); o0.y = pk2(f[2], f[3]); o0.z = pk2(f[4], f[5]); o0.w = pk2(f[6], f[7]); o1.x = pk2(f[8], f[9]); o1.y = pk2(f[10], f[11]); o1.z = pk2(f[12], f[13]); o1.w = pk2(f[14], f[15]);
        *(GAS v4u*)row = o0; *(GAS v4u*)(row + 8) = o1; }
}
__device__ __forceinline__ void a_kmean(const Ctx& C, const bf16* QKV, float* kmean) {
    const int gw = C.vcu * NWAVES + C.wave, NGW = C.G * NWAVES, r8 = C.lane >> 3, sub = C.lane & 7;
    for (int u = gw; u < 2 * 8 * 32; u += NGW) { const int b = u >> 8, h = (u >> 5) & 7, n = u & 31;
        const bf16* Kp = QKV + ((size_t)b * SEQ + 256 * n + r8) * INC + KB_OFF + h * 64 + sub * 8;
        float acc[8];
#pragma unroll
        for (int i = 0; i < 8; ++i) acc[i] = 0.f;
#pragma unroll 4
        for (int it = 0; it < 32; ++it) { const v4u w = *(const GAS v4u*)(Kp + (size_t)it * 8 * INC); float f[8]; unpack8(w, f);
#pragma unroll
            for (int i = 0; i < 8; ++i) acc[i] += f[i]; }
#pragma unroll
        for (int i = 0; i < 8; ++i) { float v = acc[i]; v += __shfl_xor(v, 8); v += __shfl_xor(v, 16); v += __shfl_xor(v, 32); acc[i] = v * (1.0f / 256.0f); }
        if (r8 == 0) { float* o = kmean + (size_t)u * 64 + sub * 8;
            *(GAS f32x4*)o = (f32x4){acc[0], acc[1], acc[2], acc[3]}; *(GAS f32x4*)(o + 4) = (f32x4){acc[4], acc[5], acc[6], acc[7]}; }
    }
}
struct PairAcc { float m, l, o[8]; };
__device__ __forceinline__ void pair_attend(PairAcc& A, const float (&q)[8], const bf16* Kp, const bf16* Vp, int nk, int dist0, const LAS float* tbl) {
    for (int j = 0; j < nk; ++j) {
        const v4u kw = *(const GAS v4u*)(Kp + (size_t)j * INC); const v4u vw = *(const GAS v4u*)(Vp + (size_t)j * INC);
        float kf[8], vf[8]; unpack8(kw, kf); unpack8(vw, vf);
        float s = 0.f;
#pragma unroll
        for (int i = 0; i < 8; ++i) s += q[i] * kf[i];
        s += __shfl_xor(s, 1); s += __shfl_xor(s, 2); s += __shfl_xor(s, 4);
        const int dist = dist0 - j; s += tbl[dist < 128 ? dist : 128];
        const float mn = fmaxf(A.m, s), sc = __expf(A.m - mn), p = __expf(s - mn);
        A.l = A.l * sc + p;
#pragma unroll
        for (int i = 0; i < 8; ++i) A.o[i] = A.o[i] * sc + p * vf[i];
        A.m = mn;
    }
}
__device__ __forceinline__ void store_o8(bf16* p, const float (&o)[8], float inv) {
    v4u w; w.x = pk2(o[0] * inv, o[1] * inv); w.y = pk2(o[2] * inv, o[3] * inv); w.z = pk2(o[4] * inv, o[5] * inv); w.w = pk2(o[6] * inv, o[7] * inv);
    *(GAS v4u*)p = w;
}
__device__ __forceinline__ void moba_scalar_unit(const Ctx& C, int u, const bf16* QKV, const float* kmean, const float* rel_bias, bf16* O) {
    LAS float* tbl = (LAS float*)(C.lds + RING_OFF); LAS float* km = (LAS float*)(C.lds + RING_OFF + 1024); LAS int* selb = (LAS int*)(C.lds + RING_OFF + 1024 + 8192) + C.wave * 64;
    const int gi = C.lane >> 3, sub = C.lane & 7;
    {
            const int b = u >> 9, h = (u >> 6) & 7, ci = u & 63, cur = ci >> 1;
            if (C.tid <= 128) tbl[C.tid] = rel_bias[T5B[C.tid] * 16 + 8 + h];
            for (int i = C.tid; i < 32 * 64; i += NTHR) km[i] = kmean[(size_t)((b * 8 + h) * 32) * 64 + i];
            __syncthreads();
            const size_t rowb = (size_t)b * SEQ; const int qw0 = ci * 128 + C.wave * 16;
            { const int ql = C.lane >> 2, part = C.lane & 3; const bf16* qp = QKV + (rowb + qw0 + ql) * INC + QB_OFF + h * 64;
              float g[8];
#pragma unroll
              for (int t = 0; t < 8; ++t) g[t] = 0.f;
#pragma unroll
              for (int c = 0; c < 8; ++c) { const v4u w = *(const GAS v4u*)(qp + 8 * c); float qf[8]; unpack8(w, qf);
#pragma unroll
                  for (int t = 0; t < 8; ++t) { const LAS float* kr = km + (part + 4 * t) * 64 + 8 * c;
#pragma unroll
                      for (int i = 0; i < 8; ++i) g[t] += qf[i] * kr[i]; } }
#pragma unroll
              for (int t = 0; t < 8; ++t) if (part + 4 * t >= cur) g[t] = -INFINITY;
#pragma unroll
              for (int r = 0; r < 3; ++r) { float bv = -INFINITY; int bi = 1000;
#pragma unroll
                  for (int t = 0; t < 8; ++t) if (g[t] > bv) { bv = g[t]; bi = part + 4 * t; }
#pragma unroll
                  for (int off = 1; off <= 2; off <<= 1) { const float ov = __shfl_xor(bv, off); const int oi = __shfl_xor(bi, off); if (ov > bv || (ov == bv && oi < bi)) { bv = ov; bi = oi; } }
                  if (part == 0) selb[ql * 4 + r] = (bv > -INFINITY) ? bi : -1;
#pragma unroll
                  for (int t = 0; t < 8; ++t) if (part + 4 * t == bi) g[t] = -INFINITY; } }
            LDS_WAIT(); __syncthreads();
            const int slot = gi & 3;
            for (int qq = 0; qq < 8; ++qq) { const int ql = 2 * qq + (gi >> 2), i = qw0 + ql;
                const bf16* qp = QKV + (rowb + i) * INC + QB_OFF + h * 64 + sub * 8; float q[8]; { const v4u w = *(const GAS v4u*)qp; unpack8(w, q); }
#pragma unroll
                for (int t = 0; t < 8; ++t) q[t] *= 0.125f;
                int n, nk, dist0;
                if (slot < 3) { n = selb[ql * 4 + slot]; nk = n >= 0 ? 256 : 0; if (n < 0) n = 0; dist0 = i - 256 * n; }
                else { n = cur; nk = i - 256 * cur + 1; dist0 = i - 256 * cur; }
                const bf16* Kp = QKV + (rowb + 256 * n) * INC + KB_OFF + h * 64 + sub * 8; const bf16* Vp = Kp + (VB_OFF - KB_OFF);
                PairAcc A; A.m = -INFINITY; A.l = 0.f;
#pragma unroll
                for (int t = 0; t < 8; ++t) A.o[t] = 0.f;
                pair_attend(A, q, Kp, Vp, nk, dist0, tbl);
                float mx = A.m; mx = fmaxf(mx, __shfl_xor(mx, 8)); mx = fmaxf(mx, __shfl_xor(mx, 16));
                const float f = (A.m == -INFINITY) ? 0.f : __expf(A.m - mx);
                float L = A.l * f; L += __shfl_xor(L, 8); L += __shfl_xor(L, 16);
                float o[8];
#pragma unroll
                for (int t = 0; t < 8; ++t) { float v = A.o[t] * f; v += __shfl_xor(v, 8); v += __shfl_xor(v, 16); o[t] = v; }
                if (slot == 0) store_o8(O + (rowb + i) * D + 512 + h * 64 + sub * 8, o, 1.0f / L);
            }
            }
}
__device__ __forceinline__ void swa_scalar_unit(const Ctx& C, int u, const bf16* QKV, const float* rel_bias, const float* sinks, bf16* O) {
    LAS float* tbl = (LAS float*)(C.lds + RING_OFF);
    const int gi = C.lane >> 3, sub = C.lane & 7;
    {
            const int v = u, b = v >> 9, hq = (v >> 6) & 7, ci = v & 63, kvh = hq >> 2;
            if (C.tid <= 128) tbl[C.tid] = rel_bias[T5B[C.tid] * 16 + hq];
            __syncthreads();
            const size_t rowb = (size_t)b * SEQ; const int qw0 = ci * 128 + C.wave * 16; const float sink = sinks[hq];
            for (int qq = 0; qq < 2; ++qq) { const int ql = 8 * qq + gi, i = qw0 + ql;
                const bf16* qp = QKV + (rowb + i) * INC + QA_OFF + hq * 64 + sub * 8; float q[8]; { const v4u w = *(const GAS v4u*)qp; unpack8(w, q); }
#pragma unroll
                for (int t = 0; t < 8; ++t) q[t] *= 0.125f;
                const int klo = i >= 127 ? i - 127 : 0, nk = i - klo + 1, dist0 = i - klo;
                const bf16* Kp = QKV + (rowb + klo) * INC + KA_OFF + kvh * 64 + sub * 8; const bf16* Vp = Kp + (VA_OFF - KA_OFF);
                PairAcc A; A.m = -INFINITY; A.l = 0.f;
#pragma unroll
                for (int t = 0; t < 8; ++t) A.o[t] = 0.f;
                pair_attend(A, q, Kp, Vp, nk, dist0, tbl);
                const float mx = fmaxf(A.m, sink), f = __expf(A.m - mx), L = A.l * f + __expf(sink - mx);
                store_o8(O + (rowb + i) * D + hq * 64 + sub * 8, A.o, f / L);
            }
    }
}
namespace at {
typedef short bf16x8 __attribute__((ext_vector_type(8)));
typedef short s16x4 __attribute__((ext_vector_type(4)));
typedef float f32x16 __attribute__((ext_vector_type(16)));
typedef float f32x2_t __attribute__((ext_vector_type(2))); typedef __bf16 bf16x2_t __attribute__((ext_vector_type(2)));
constexpr float LOG2E = 1.4426950408889634f, C2 = 0.125f * LOG2E, NEGB = -1.0e30f;
constexpr int SLOTB = 8192;
constexpr int L_K = 0, L_V = 4 * SLOTB, L_TBL = 8 * SLOTB, L_WSF = L_TBL + 4 * 132 * 4, L_KM = L_WSF + 8 * 64 * 4, L_CNT = L_KM + 32 * 64 * 4, L_LIST = L_CNT + 64, L_END = L_LIST + 16384;
static_assert(L_END <= RING_BYTES, "attention LDS map");
__device__ __forceinline__ int crow(int r, int hi) { return (r & 3) + 8 * (r >> 2) + 4 * hi; }
__device__ __forceinline__ unsigned cvtpk(float lo, float hi) { f32x2_t v = {lo, hi}; bf16x2_t b = __builtin_convertvector(v, bf16x2_t); return __builtin_bit_cast(unsigned, b); }
#define AT_SBAR() __builtin_amdgcn_sched_barrier(0)
__device__ __forceinline__ void qkt(f32x16& p0, f32x16& p1, const LAS char* Kslot, const bf16x8 (&qr)[4], int r32, int hi) {
    const LAS char* kb = Kslot + hi * 1024 + r32 * 16;
    f32x16 z;
#pragma unroll
    for (int i = 0; i < 16; ++i) z[i] = 0.f;
#pragma unroll
    for (int d0 = 0; d0 < 4; ++d0) {
        const bf16x8 b0 = *(const LAS bf16x8*)(kb + d0 * 2048);
        const bf16x8 b1 = *(const LAS bf16x8*)(kb + d0 * 2048 + 512);
        if (d0 == 0) { p0 = __builtin_amdgcn_mfma_f32_32x32x16_bf16(b0, qr[0], z, 0, 0, 0); p1 = __builtin_amdgcn_mfma_f32_32x32x16_bf16(b1, qr[0], z, 0, 0, 0); }
        else { p0 = __builtin_amdgcn_mfma_f32_32x32x16_bf16(b0, qr[d0], p0, 0, 0, 0); p1 = __builtin_amdgcn_mfma_f32_32x32x16_bf16(b1, qr[d0], p1, 0, 0, 0); } }
}
__device__ __forceinline__ void pv(f32x16 (&o)[2], int vb, bf16x8 pa0, bf16x8 pa1, bf16x8 pa2, bf16x8 pa3) {
#pragma unroll
    for (int d0 = 0; d0 < 2; ++d0) { s16x4 lo[4], hi[4];
#pragma unroll
        for (int ks = 0; ks < 4; ++ks) {
            asm volatile("ds_read_b64_tr_b16 %0,%1 offset:%c2" : "=&v"(lo[ks]) : "v"(vb), "i"(d0 * 4096 + ks * 1024) : "memory");
            asm volatile("ds_read_b64_tr_b16 %0,%1 offset:%c2" : "=&v"(hi[ks]) : "v"(vb), "i"(d0 * 4096 + ks * 1024 + 512) : "memory"); }
        asm volatile("s_waitcnt lgkmcnt(0)" ::: "memory"); AT_SBAR();
#define AT_PK(k) (bf16x8){lo[k][0], lo[k][1], lo[k][2], lo[k][3], hi[k][0], hi[k][1], hi[k][2], hi[k][3]}
        o[d0] = __builtin_amdgcn_mfma_f32_32x32x16_bf16(pa0, AT_PK(0), o[d0], 0, 0, 0);
        o[d0] = __builtin_amdgcn_mfma_f32_32x32x16_bf16(pa1, AT_PK(1), o[d0], 0, 0, 0);
        o[d0] = __builtin_amdgcn_mfma_f32_32x32x16_bf16(pa2, AT_PK(2), o[d0], 0, 0, 0);
        o[d0] = __builtin_amdgcn_mfma_f32_32x32x16_bf16(pa3, AT_PK(3), o[d0], 0, 0, 0);
#undef AT_PK
    }
}
__device__ __forceinline__ int vbase(int lane, int hi) { return ((lane >> 4) & 1) * 32 + (lane & 3) * 8 + (4 * hi + ((lane & 15) >> 2)) * 64; }
__device__ __forceinline__ void scale_o(f32x16 (&o)[2], LAS float* wsf, float f, int r32, int hi) {
    if (hi == 0) wsf[r32] = f;
    asm volatile("s_waitcnt lgkmcnt(0)" ::: "memory");
#pragma unroll
    for (int r = 0; r < 16; ++r) { const float g = wsf[crow(r, hi)]; o[0][r] *= g; o[1][r] *= g; }
    asm volatile("s_waitcnt lgkmcnt(0)" ::: "memory");
}
__device__ __forceinline__ void tile_softmax_pv(f32x16& s0, f32x16& s1, float& m, float& l, f32x16 (&o)[2], int vb, LAS float* wsf, int r32, int hi) {
    float mt = fmaxf(s0[0], s1[0]);
#pragma unroll
    for (int r = 1; r < 16; ++r) mt = fmaxf(mt, fmaxf(s0[r], s1[r]));
    mt = fmaxf(mt, __shfl_xor(mt, 32));
    const float mn = fmaxf(m, mt), alpha = __builtin_amdgcn_exp2f(m - mn);
    float rs = 0.f;
#pragma unroll
    for (int r = 0; r < 16; ++r) { s0[r] = __builtin_amdgcn_exp2f(s0[r] - mn); s1[r] = __builtin_amdgcn_exp2f(s1[r] - mn); rs += s0[r] + s1[r]; }
    l = l * alpha + rs; m = mn;
    if (__any(alpha != 1.0f)) scale_o(o, wsf, alpha, r32, hi);
    v4u w0, w1, w2, w3;
    w0.x = cvtpk(s0[0], s0[1]); w0.y = cvtpk(s0[2], s0[3]); w0.z = cvtpk(s0[4], s0[5]); w0.w = cvtpk(s0[6], s0[7]);
    w1.x = cvtpk(s0[8], s0[9]); w1.y = cvtpk(s0[10], s0[11]); w1.z = cvtpk(s0[12], s0[13]); w1.w = cvtpk(s0[14], s0[15]);
    w2.x = cvtpk(s1[0], s1[1]); w2.y = cvtpk(s1[2], s1[3]); w2.z = cvtpk(s1[4], s1[5]); w2.w = cvtpk(s1[6], s1[7]);
    w3.x = cvtpk(s1[8], s1[9]); w3.y = cvtpk(s1[10], s1[11]); w3.z = cvtpk(s1[12], s1[13]); w3.w = cvtpk(s1[14], s1[15]);
    AT_SBAR();
    pv(o, vb, __builtin_bit_cast(bf16x8, w0), __builtin_bit_cast(bf16x8, w1), __builtin_bit_cast(bf16x8, w2), __builtin_bit_cast(bf16x8, w3));
}
__device__ __forceinline__ void stage_kv(LAS char* lds, const bf16* Kg, const bf16* Vg, int t0, int t1, int tid) {
    const int key = tid >> 3, c = tid & 7;
    const int kd = L_K + c * 1024 + key * 16, vd = L_V + ((c >> 2) * 4 + (key >> 4)) * 1024 + (key & 15) * 64 + (c & 3) * 16;
    v4u kw[4], vw[4];
#pragma unroll
    for (int t = 0; t < 4; ++t) if (t >= t0 && t < t1) { kw[t] = *(const GAS v4u*)(Kg + (ptrdiff_t)(64 * t + key) * INC + 8 * c); vw[t] = *(const GAS v4u*)(Vg + (ptrdiff_t)(64 * t + key) * INC + 8 * c); }
#pragma unroll
    for (int t = 0; t < 4; ++t) if (t >= t0 && t < t1) { *(LAS v4u*)(lds + kd + t * SLOTB) = kw[t]; *(LAS v4u*)(lds + vd + t * SLOTB) = vw[t]; }
}
__device__ __forceinline__ void load_q(bf16x8 (&qr)[4], const bf16* qrow, int hi) {
#pragma unroll
    for (int d0 = 0; d0 < 4; ++d0) qr[d0] = *(const GAS bf16x8*)(qrow + 16 * d0 + 8 * hi);
}
__device__ __forceinline__ void zero_o(f32x16 (&o)[2]) {
#pragma unroll
    for (int i = 0; i < 16; ++i) { o[0][i] = 0.f; o[1][i] = 0.f; }
}

__device__ __forceinline__ void swa_unit(const Ctx& C, int u, const bf16* QKV, const float* rel_bias, const float* sinks, bf16* O) {
    const int b = u >> 7, kvh = (u >> 6) & 1, blk = u & 63, r32 = C.lane & 31, hi = C.lane >> 5;
    LAS char* lds = (LAS char*)C.lds; LAS float* tbl = (LAS float*)(lds + L_TBL); LAS float* wsf = (LAS float*)(lds + L_WSF) + C.wave * 64;
    for (int i = C.tid; i < 4 * 129; i += NTHR) { const int g = i / 129, d = i % 129; tbl[g * 132 + d] = rel_bias[T5B[d] * 16 + kvh * 4 + g] * LOG2E; }
    const size_t rowb = (size_t)b * SEQ;
    const bf16* Kg = QKV + ((ptrdiff_t)rowb + 128 * (blk - 1)) * INC + KA_OFF + kvh * 64;
    stage_kv(lds, Kg, Kg + (VA_OFF - KA_OFF), blk == 0 ? 2 : 0, 4, C.tid);
    asm volatile("s_waitcnt lgkmcnt(0)" ::: "memory"); __syncthreads();
    const int vb = (int)(unsigned)(uintptr_t)(lds + L_V) + vbase(C.lane, hi);
    for (int qi = 0; qi < 2; ++qi) { const int ti = 2 * C.wave + qi, g = ti >> 2, t = ti & 3, hq = kvh * 4 + g;
        bf16x8 qr[4]; load_q(qr, QKV + (rowb + 128 * blk + 32 * t + r32) * INC + QA_OFF + hq * 64, hi);
        float m = NEGB, l = 0.f; f32x16 o[2]; zero_o(o);
        const LAS float* tg = tbl + g * 132; const int qrel = 128 + 32 * t + r32;
        int jlo = t < 2 ? 0 : 1; const int jhi = jlo + 3; if (blk == 0 && jlo < 2) jlo = 2;
        for (int j = jlo; j < jhi; ++j) { f32x16 s0, s1; qkt(s0, s1, lds + L_K + j * SLOTB, qr, r32, hi);
#pragma unroll
            for (int r = 0; r < 16; ++r) { const int d0 = qrel - (64 * j + crow(r, hi)), d1 = d0 - 32; const bool v0 = (unsigned)d0 < 128u, v1 = (unsigned)d1 < 128u;
                const float b0 = tg[v0 ? d0 : 0], b1 = tg[v1 ? d1 : 0];
                s0[r] = v0 ? s0[r] * C2 + b0 : NEGB; s1[r] = v1 ? s1[r] * C2 + b1 : NEGB; }
            tile_softmax_pv(s0, s1, m, l, o, vb + j * SLOTB, wsf, r32, hi); }
        l += __shfl_xor(l, 32);
        const float den = l + __builtin_amdgcn_exp2f(sinks[hq] * LOG2E - m);
        scale_o(o, wsf, 1.0f / den, r32, hi);
        bf16* Ob = O + (rowb + 128 * blk + 32 * t) * D + hq * 64 + r32;
#pragma unroll
        for (int r = 0; r < 16; ++r) { bf16* p = Ob + (size_t)crow(r, hi) * D; p[0] = (bf16)f2bf(o[0][r]); p[32] = (bf16)f2bf(o[1][r]); }
    }
}
}

namespace at {
__device__ __forceinline__ void moba_own_unit(const Ctx& C, int bh, int cur, const bf16* QKV, const float* kmean, const float* rel_bias, unsigned* sel, float* Po, float* Pml) {
    const int b = bh >> 3, h = bh & 7, r32 = C.lane & 31, hi = C.lane >> 5;
    LAS char* lds = (LAS char*)C.lds; LAS float* tbl = (LAS float*)(lds + L_TBL); LAS float* wsf = (LAS float*)(lds + L_WSF) + C.wave * 64; LAS float* km = (LAS float*)(lds + L_KM);
    if (C.tid <= 128) tbl[C.tid] = rel_bias[T5B[C.tid] * 16 + 8 + h] * LOG2E;
    for (int i = C.tid; i < 32 * 64; i += NTHR) km[i] = kmean[(size_t)bh * 2048 + i];
    const size_t rowb = (size_t)b * SEQ;
    const bf16* Kg = QKV + (rowb + 256 * cur) * INC + KB_OFF + h * 64;
    stage_kv(lds, Kg, Kg + (VB_OFF - KB_OFF), 0, 4, C.tid);
    asm volatile("s_waitcnt lgkmcnt(0)" ::: "memory"); __syncthreads();
    for (int pass = 0; pass < 2; ++pass) { const int ql = C.lane >> 2, part = C.lane & 3, q = 256 * cur + pass * 128 + C.wave * 16 + ql; const bf16* qp = QKV + (rowb + q) * INC + QB_OFF + h * 64;
        float g[8];
#pragma unroll
        for (int t = 0; t < 8; ++t) g[t] = 0.f;
#pragma unroll 1
        for (int c = 0; c < 8; ++c) { const v4u w = *(const GAS v4u*)(qp + 8 * c); float qf[8]; unpack8(w, qf);
#pragma unroll
            for (int t = 0; t < 8; ++t) { const LAS float* kr = km + (part + 4 * t) * 64 + 8 * c;
#pragma unroll
                for (int i = 0; i < 8; ++i) g[t] += qf[i] * kr[i]; } }
#pragma unroll
        for (int t = 0; t < 8; ++t) if (part + 4 * t >= cur) g[t] = -INFINITY;
        unsigned word = 0u;
#pragma unroll
        for (int r = 0; r < 3; ++r) { float bv = -INFINITY; int bi = 1000;
#pragma unroll
            for (int t = 0; t < 8; ++t) if (g[t] > bv) { bv = g[t]; bi = part + 4 * t; }
#pragma unroll
            for (int off = 1; off <= 2; off <<= 1) { const float ov = __shfl_xor(bv, off); const int oi = __shfl_xor(bi, off); if (ov > bv || (ov == bv && oi < bi)) { bv = ov; bi = oi; } }
            word |= ((bv > -INFINITY) ? (unsigned)bi : 255u) << (8 * r);
#pragma unroll
            for (int t = 0; t < 8; ++t) if (part + 4 * t == bi) g[t] = -INFINITY; }
        if (part == 0) sel[(size_t)bh * SEQ + q] = word; }
    const int vb = (int)(unsigned)(uintptr_t)(lds + L_V) + vbase(C.lane, hi);
    const int q0 = 256 * cur + 32 * C.wave, qrel = 32 * C.wave + r32;
    bf16x8 qr[4]; load_q(qr, QKV + (rowb + q0 + r32) * INC + QB_OFF + h * 64, hi);
    float m = NEGB, l = 0.f; f32x16 o[2]; zero_o(o);
    for (int j = 0; j <= (C.wave >> 1); ++j) { f32x16 s0, s1; qkt(s0, s1, lds + L_K + j * SLOTB, qr, r32, hi);
#pragma unroll
        for (int r = 0; r < 16; ++r) { const int d0 = qrel - (64 * j + crow(r, hi)), d1 = d0 - 32; const bool v0 = d0 >= 0, v1 = d1 >= 0;
            const float b0 = tbl[v0 ? (d0 < 128 ? d0 : 128) : 0], b1 = tbl[v1 ? (d1 < 128 ? d1 : 128) : 0];
            s0[r] = v0 ? s0[r] * C2 + b0 : NEGB; s1[r] = v1 ? s1[r] * C2 + b1 : NEGB; }
        tile_softmax_pv(s0, s1, m, l, o, vb + j * SLOTB, wsf, r32, hi); }
    l += __shfl_xor(l, 32);
    float* pob = Po + (((size_t)bh * SEQ + q0) * 4 + 3) * 64 + r32;
#pragma unroll
    for (int r = 0; r < 16; ++r) { float* p = pob + (size_t)crow(r, hi) * 256; p[0] = o[0][r]; p[32] = o[1][r]; }
    if (hi == 0) { float* p = Pml + (((size_t)bh * SEQ + q0 + r32) * 4 + 3) * 2; *(GAS f32x2_t*)p = (f32x2_t){m, l}; }
}
__device__ __forceinline__ void moba_gather_item(const Ctx& C, int bh, int n, int c0, int c1, const bf16* QKV, const float* rel_bias, const unsigned* sel, float* Po, float* Pml) {
    const int b = bh >> 3, h = bh & 7, r32 = C.lane & 31, hi = C.lane >> 5;
    LAS char* lds = (LAS char*)C.lds; LAS float* tbl = (LAS float*)(lds + L_TBL); LAS float* wsf = (LAS float*)(lds + L_WSF) + C.wave * 64;
    LAS unsigned* cnt = (LAS unsigned*)(lds + L_CNT); LAS unsigned short* list = (LAS unsigned short*)(lds + L_LIST);
    if (C.tid <= 128) tbl[C.tid] = rel_bias[T5B[C.tid] * 16 + 8 + h] * LOG2E;
    const size_t rowb = (size_t)b * SEQ;
    const bf16* Kg = QKV + (rowb + 256 * n) * INC + KB_OFF + h * 64;
    stage_kv(lds, Kg, Kg + (VB_OFF - KB_OFF), 0, 4, C.tid);
    const unsigned* selp = sel + (size_t)bh * SEQ; const int nch = 4 * (c1 - c0);
    int myc = 0;
    for (int ch = C.wave; ch < nch; ch += NWAVES) { const unsigned w = selp[256 * c0 + 64 * ch + C.lane];
        const bool mt = ((w & 255u) == (unsigned)n) || (((w >> 8) & 255u) == (unsigned)n) || (((w >> 16) & 255u) == (unsigned)n);
        myc += __popcll(__ballot(mt)); }
    if (C.lane == 0) cnt[C.wave] = (unsigned)myc;
    asm volatile("s_waitcnt lgkmcnt(0)" ::: "memory"); __syncthreads();
    int base = 0, total = 0;
#pragma unroll
    for (int w = 0; w < NWAVES; ++w) { const int c = (int)cnt[w]; if (w < C.wave) base += c; total += c; }
    { int pos = base;
      for (int ch = C.wave; ch < nch; ch += NWAVES) { const int q = 256 * c0 + 64 * ch + C.lane; const unsigned w = selp[q];
        const int sl = ((w & 255u) == (unsigned)n) ? 0 : (((w >> 8) & 255u) == (unsigned)n) ? 1 : (((w >> 16) & 255u) == (unsigned)n) ? 2 : -1;
        const unsigned long long mask = __ballot(sl >= 0);
        if (sl >= 0) list[pos + __popcll(mask & ((1ull << C.lane) - 1ull))] = (unsigned short)((q << 2) | sl);
        pos += __popcll(mask); } }
    asm volatile("s_waitcnt lgkmcnt(0)" ::: "memory"); __syncthreads();
    const int vb = (int)(unsigned)(uintptr_t)(lds + L_V) + vbase(C.lane, hi);
    const int ntile = (total + 31) >> 5;
    for (int tile = C.wave; tile < ntile; tile += NWAVES) {
        const int idx = 32 * tile + r32; const unsigned e = list[idx < total ? idx : total - 1]; const int q = (int)(e >> 2);
        bf16x8 qr[4]; load_q(qr, QKV + (rowb + q) * INC + QB_OFF + h * 64, hi);
        float m = NEGB, l = 0.f; f32x16 o[2]; zero_o(o);
        const int dq = q - 256 * n;
#pragma unroll 1
        for (int j = 0; j < 4; ++j) { f32x16 s0, s1; qkt(s0, s1, lds + L_K + j * SLOTB, qr, r32, hi);
#pragma unroll
            for (int r = 0; r < 16; ++r) { const int d0 = dq - (64 * j + crow(r, hi)), d1 = d0 - 32;
                s0[r] = s0[r] * C2 + tbl[d0 < 128 ? d0 : 128]; s1[r] = s1[r] * C2 + tbl[d1 < 128 ? d1 : 128]; }
            tile_softmax_pv(s0, s1, m, l, o, vb + j * SLOTB, wsf, r32, hi); }
        l += __shfl_xor(l, 32);
#pragma unroll
        for (int r = 0; r < 16; ++r) { const int ri = 32 * tile + crow(r, hi);
            if (ri < total) { const unsigned e2 = list[ri]; float* p = Po + (((size_t)bh * SEQ + (e2 >> 2)) * 4 + (e2 & 3u)) * 64 + r32; p[0] = o[0][r]; p[32] = o[1][r]; } }
        if (hi == 0 && idx < total) { float* p = Pml + (((size_t)bh * SEQ + q) * 4 + (e & 3u)) * 2; *(GAS f32x2_t*)p = (f32x2_t){m, l}; }
    }
}
}
__device__ __forceinline__ void t_merge_norm(const Ctx& C, const unsigned* sel, const float* Po, const float* Pml, bf16* O, const float* gg) {
    const int gw = C.vcu * NWAVES + C.wave, NGW = C.G * NWAVES, h = C.lane >> 3, dsub = C.lane & 7;
    for (int m = gw; m < M; m += NGW) { const int b = m >> 13, q = m & (SEQ - 1); const size_t pi = ((size_t)(b * 8 + h) * SEQ + q);
        const unsigned w = sel[pi];
        float ms[4], ls[4]; bool ok[4];
#pragma unroll
        for (int s = 0; s < 4; ++s) { ok[s] = (s == 3) || (((w >> (8 * s)) & 255u) != 255u); const at::f32x2_t ml = *(const GAS at::f32x2_t*)(Pml + (pi * 4 + s) * 2); ms[s] = ok[s] ? ml.x : -INFINITY; ls[s] = ok[s] ? ml.y : 0.f; }
        const float mx = fmaxf(fmaxf(ms[0], ms[1]), fmaxf(ms[2], ms[3]));
        float acc[8], L = 0.f;
#pragma unroll
        for (int i = 0; i < 8; ++i) acc[i] = 0.f;
#pragma unroll
        for (int s = 0; s < 4; ++s) { const float f = ok[s] ? __builtin_amdgcn_exp2f(ms[s] - mx) : 0.f; L += f * ls[s];
            const float* p = Po + (pi * 4 + s) * 64 + 8 * dsub; const f32x4 a0 = *(const GAS f32x4*)p, a1 = *(const GAS f32x4*)(p + 4);
            if (ok[s]) { acc[0] += f * a0.x; acc[1] += f * a0.y; acc[2] += f * a0.z; acc[3] += f * a0.w; acc[4] += f * a1.x; acc[5] += f * a1.y; acc[6] += f * a1.z; acc[7] += f * a1.w; } }
        const float inv = 1.0f / L; float ssb = 0.f;
#pragma unroll
        for (int i = 0; i < 8; ++i) { acc[i] *= inv; ssb += acc[i] * acc[i]; }
        bf16* row = O + (size_t)m * D + 8 * C.lane;
        float a[8]; { const v4u wa = *(const GAS v4u*)row; unpack8(wa, a); }
        float ssa = 0.f;
#pragma unroll
        for (int i = 0; i < 8; ++i) ssa += a[i] * a[i];
        const float ra = 1.0f / sqrtf(wave_sum(ssa) * (1.0f / 512.0f) + EPS), rb = 1.0f / sqrtf(wave_sum(ssb) * (1.0f / 512.0f) + EPS);
        const float* ga = gg + 8 * C.lane; const float* gb = gg + 512 + 8 * C.lane;
        v4u oa, ob;
        oa.x = pk2(a[0] * ra * ga[0], a[1] * ra * ga[1]); oa.y = pk2(a[2] * ra * ga[2], a[3] * ra * ga[3]); oa.z = pk2(a[4] * ra * ga[4], a[5] * ra * ga[5]); oa.w = pk2(a[6] * ra * ga[6], a[7] * ra * ga[7]);
        ob.x = pk2(acc[0] * rb * gb[0], acc[1] * rb * gb[1]); ob.y = pk2(acc[2] * rb * gb[2], acc[3] * rb * gb[3]); ob.z = pk2(acc[4] * rb * gb[4], acc[5] * rb * gb[5]); ob.w = pk2(acc[6] * rb * gb[6], acc[7] * rb * gb[7]);
        *(GAS v4u*)row = oa; *(GAS v4u*)(row + 512) = ob; }
}
#ifndef ATTN_MODE
#define ATTN_MODE 2
#endif
constexpr int PB_NI = 75;
__device__ const unsigned PB_FLAT[PB_NI] = {196864,328448,525568,788480,1182720,1774080,2104064,262657,394241,591361,919809,1379841,2102529,328450,525570,788482,1248258,1905410,2104578,394243,656899,1051139,1642499,2103555,525572,788484,1182724,1774084,2104068,656901,1051141,1642501,2103557,722694,1116934,1642758,2103558,854023,1379591,2102535,919816,1445384,2102792,985609,1511177,2103049,1051402,1511434,2103050,1313803,2102283,1379596,2102540,1445389,2102797,1445646,2102798,1511439,2103055,1577232,2103312,2101777,2102034,2102291,2102548,2102805,2103062,2103319,2103576,2103833,2104090,2104347,2104604,2104861,2105118};
__device__ const unsigned PB_ORDER[2 * PB_NI] = {50397184,386861312,370085376,538510848,538640384,67240192,386861313,370085377,538515456,538641408,50397185,151388416,420546048,538510080,538581248,67240193,151388417,420546049,538510592,538581249,538054912,100925697,454164481,538447873,538510849,538054913,100926209,454165505,538449665,538515457,84082688,285935104,454164480,538382081,538910208,84083200,285935105,454165504,538383873,538910209,84082689,100925696,353239296,538447872,538510081,84083201,100926208,353239297,538449664,538510593,168166144,420479744,302776320,538382080,538641409,168166656,420480256,302777344,538383872,538647041,168166145,420479745,302776321,538380545,538712832,168166657,420480257,302777345,538380801,538712833,538120704,235471105,252315904,403771392,538771968,538120705,235472897,252315905,403771393,538778624,336333568,235471104,201851393,538380544,538647040,336333569,235472896,201851905,538380800,538640385,218629888,370018305,538247425,538316288,218629889,370019585,538248961,538318080,134545408,185009664,201851904,386927105,134545920,185009665,201850881,386928385,134546432,319554048,201850880,386927104,538771969,134545409,319554049,201851392,386928384,538778625,134545921,370018304,538250240,538314752,538844416,134546433,370019584,538252288,538316032,538844417,353175296,538184448,487784960,538314753,353176576,538186496,487784961,538316033,353175297,538184449,538247424,269158912,353176577,538186497,538248960,269158913,269091584,269091585,538250241,538316289,269092096,269092097,538252289,538318081};
__device__ const unsigned short PB_OFFS[33] = {0,5,10,15,20,25,30,35,40,45,50,55,60,65,70,75,80,85,90,94,98,102,106,111,116,121,126,130,134,138,142,146,150};

__device__ __forceinline__ void a_attention(const Ctx& C, const bf16* QKV, const float* kmean, const float* rel_bias, const float* sinks, bf16* O, unsigned* sel, float* Po, float* Pml) {
#if ATTN_MODE == 0
    for (int u = C.vcu; u < 2048; u += C.G) { __syncthreads(); if (u < 1024) moba_scalar_unit(C, u, QKV, kmean, rel_bias, O); else swa_scalar_unit(C, u - 1024, QKV, rel_bias, sinks, O); }
#elif ATTN_MODE == 1
    for (int u = C.vcu; u < 1024 + 256; u += C.G) { __syncthreads(); if (u < 1024) moba_scalar_unit(C, u, QKV, kmean, rel_bias, O); else at::swa_unit(C, u - 1024, QKV, rel_bias, sinks, O); }
#else
    for (int k = 0;; ++k) { int kind, a0, a1 = 0;
        if (C.G == 256) { if (k >= 3) break; if (k < 2) { kind = 0; a0 = 2 * (C.vcu >> 5) + k; a1 = C.vcu & 31; } else { kind = 1; a0 = C.vcu; } }
        else { const int u = C.vcu + k * C.G; if (u >= 512 + 256) break; if (u < 512) { kind = 0; a0 = u >> 5; a1 = u & 31; } else { kind = 1; a0 = u - 512; } }
        __syncthreads();
        if (kind == 0) at::moba_own_unit(C, a0, a1, QKV, kmean, rel_bias, sel, Po, Pml); else at::swa_unit(C, a0, QKV, rel_bias, sinks, O); }
#endif
}
__device__ __forceinline__ void a_gather(const Ctx& C, const bf16* QKV, const float* rel_bias, const unsigned* sel, float* Po, float* Pml) {
    const bool tab = (C.G == 256); const int x = C.vcu >> 5, c = C.vcu & 31;
    const int k0 = tab ? (int)PB_OFFS[c] : C.vcu, k1 = tab ? (int)PB_OFFS[c + 1] : 16 * PB_NI, dk = tab ? 1 : C.G;
    for (int k = k0; k < k1; k += dk) { int bh, n, c0, c1;
        if (tab) { const unsigned it = PB_ORDER[k]; bh = 2 * x + (int)(it & 1u); n = (int)((it >> 8) & 255u); c0 = (int)((it >> 16) & 255u); c1 = (int)(it >> 24); }
        else { const unsigned it = PB_FLAT[k % PB_NI]; bh = k / PB_NI; n = (int)(it & 255u); c0 = (int)((it >> 8) & 255u); c1 = (int)((it >> 16) & 255u); }
        __syncthreads(); at::moba_gather_item(C, bh, n, c0, c1, QKV, rel_bias, sel, Po, Pml); }
}
struct LayerW { const bf16 *wgu0, *wd0, *wgu1, *wd1, *win, *wout; };
__device__ __forceinline__ LayerW layer_w(const unsigned char* ws, int l) {
    const unsigned char* wl = ws + WS_W + (size_t)l * W_LAYER; LayerW w;
    w.wgu0 = (const bf16*)wl; w.wd0 = (const bf16*)(wl + W_GU); w.wgu1 = (const bf16*)(wl + W_GU + W_D); w.wd1 = (const bf16*)(wl + 2 * W_GU + W_D);
    w.win = (const bf16*)(wl + 2 * W_GU + 2 * W_D); w.wout = (const bf16*)(wl + 2 * W_GU + 2 * W_D + W_IN); return w;
}
__global__ void __launch_bounds__(NTHR, 2) trunk_fwd(Args args_unused) {
    extern __shared__ __attribute__((aligned(16))) unsigned char lds[];
    { const Ctx C = make_ctx(lds);
    for (int u = C.tid; u < (LDS_BYTES - LDSCTL_OFF) / 4; u += NTHR) ((LAS unsigned*)(C.lds + LDSCTL_OFF))[u] = 0u;
    __syncthreads();
    { const Ctx C = make_ctx(lds); const KArgs ka = kargs(); (void)xcd_barrier_post((unsigned*)((gu32*)(ka->ws + WS_CTL) + CW_BAR), (volatile LAS unsigned*)(C.lds + MISC_OFF) + 8); } }
#define GRID_BAR() do { const KArgs ka_ = kargs(); XcdBarrier b_; b_.bar = (unsigned*)((gu32*)(ka_->ws + WS_CTL) + CW_BAR); b_.x = xb_xcc_id(); b_.st = (volatile LAS unsigned*)((LAS unsigned char*)lds + MISC_OFF) + 8; xcd_barrier(b_); } while (0)
#define WSP(T, off) ((T*)(ka->ws + (off)))

    { const Ctx C = make_ctx(lds); p0_prologue(C); } GRID_BAR();
    { const Ctx C = make_ctx(lds); p0_mod_final(C); } GRID_BAR();
    { const Ctx C = make_ctx(lds); const KArgs ka = kargs(); t_pre(C, ka->in[0], ka->in[5], WSP(const float, WS_MOD), 0, WSP(bf16, WS_XN)); }
    GRID_BAR();

    for (int l = 0; l < DEPTH; ++l) {
        { const Ctx C = make_ctx(lds); const KArgs ka = kargs(); const LayerW w = layer_w(ka->ws, l);
          pg8::Gemm g{WSP(const bf16, WS_XN), w.wgu0, M, NGU, D}; pg8::StaticOrder S; S.init(M, NGU, C.G, C.bid); pg8::EpiSwiGLU E{WSP(bf16, WS_H), FF};
          pg8::gemm_phase<pg8::EpiSwiGLU, pg8::StaticOrder, true, true>(C.lds + RING_OFF, g, S, E); }
        GRID_BAR();
        { const Ctx C = make_ctx(lds); const KArgs ka = kargs(); const LayerW w = layer_w(ka->ws, l);
          pg8::Gemm g{WSP(const bf16, WS_H), w.wd0, M, D, FF}; pg8::StaticOrder S; S.init(M, D, C.G, C.bid); pg8::EpiF32 E{WSP(float, WS_Y), D};
          pg8::gemm_phase<pg8::EpiF32, pg8::StaticOrder, true, true>(C.lds + RING_OFF, g, S, E); }
        GRID_BAR();
        { const Ctx C = make_ctx(lds); const KArgs ka = kargs(); const float* modl = WSP(const float, WS_MOD) + (size_t)l * 2 * NMOD;
          t_post(C, l == 0 ? ka->in[0] : (const float*)ka->out, ka->out, WSP(const float, WS_Y), ka->in[6] + (size_t)(l * 3 + 0) * D, modl, 0, 0.5f, ka->in[5] + (size_t)(l * 3 + 1) * D, modl, 3, WSP(bf16, WS_XN)); }
        GRID_BAR();
        { const Ctx C = make_ctx(lds); const KArgs ka = kargs(); const LayerW w = layer_w(ka->ws, l);
          pg8::Gemm g{WSP(const bf16, WS_XN), w.win, M, INC, D}; pg8::StaticOrder S; S.init(M, INC, C.G, C.bid); pg8::EpiBf16Bias E{WSP(bf16, WS_QKV), INC, ka->in[11] + (size_t)l * INC};
          pg8::gemm_phase<pg8::EpiBf16Bias, pg8::StaticOrder, true, true>(C.lds + RING_OFF, g, S, E); }
        GRID_BAR();
        { const Ctx C = make_ctx(lds); const KArgs ka = kargs(); a_kmean(C, WSP(const bf16, WS_QKV), WSP(float, WS_KMEAN)); }
        GRID_BAR();
        { const Ctx C = make_ctx(lds); const KArgs ka = kargs(); a_attention(C, WSP(const bf16, WS_QKV), WSP(const float, WS_KMEAN), ka->in[2], ka->in[13] + l * 8, WSP(bf16, WS_O), WSP(unsigned, WS_SEL), WSP(float, WS_PO), WSP(float, WS_PML)); }
        GRID_BAR();
#if ATTN_MODE == 2
        { const Ctx C = make_ctx(lds); const KArgs ka = kargs(); a_gather(C, WSP(const bf16, WS_QKV), ka->in[2], WSP(const unsigned, WS_SEL), WSP(float, WS_PO), WSP(float, WS_PML)); }
        GRID_BAR();
        { const Ctx C = make_ctx(lds); const KArgs ka = kargs(); t_merge_norm(C, WSP(const unsigned, WS_SEL), WSP(const float, WS_PO), WSP(const float, WS_PML), WSP(bf16, WS_O), ka->in[14] + (size_t)l * D); }
        GRID_BAR();
#else
        { const Ctx C = make_ctx(lds); const KArgs ka = kargs(); t_groupnorm(C, WSP(bf16, WS_O), ka->in[14] + (size_t)l * D); }
        GRID_BAR();
#endif
        { const Ctx C = make_ctx(lds); const KArgs ka = kargs(); const LayerW w = layer_w(ka->ws, l);
          pg8::Gemm g{WSP(const bf16, WS_O), w.wout, M, D, D}; pg8::StaticOrder S; S.init(M, D, C.G, C.bid); pg8::EpiF32 E{WSP(float, WS_Y), D};
          pg8::gemm_phase<pg8::EpiF32, pg8::StaticOrder, true, true>(C.lds + RING_OFF, g, S, E); }
        GRID_BAR();
        { const Ctx C = make_ctx(lds); const KArgs ka = kargs(); const float* modl = WSP(const float, WS_MOD) + (size_t)l * 2 * NMOD;
          t_post(C, ka->out, ka->out, WSP(const float, WS_Y), ka->in[6] + (size_t)(l * 3 + 1) * D, modl, 3, 1.0f, ka->in[5] + (size_t)(l * 3 + 2) * D, modl, 6, WSP(bf16, WS_XN)); }
        GRID_BAR();
        { const Ctx C = make_ctx(lds); const KArgs ka = kargs(); const LayerW w = layer_w(ka->ws, l);
          pg8::Gemm g{WSP(const bf16, WS_XN), w.wgu1, M, NGU, D}; pg8::StaticOrder S; S.init(M, NGU, C.G, C.bid); pg8::EpiSwiGLU E{WSP(bf16, WS_H), FF};
          pg8::gemm_phase<pg8::EpiSwiGLU, pg8::StaticOrder, true, true>(C.lds + RING_OFF, g, S, E); }
        GRID_BAR();
        { const Ctx C = make_ctx(lds); const KArgs ka = kargs(); const LayerW w = layer_w(ka->ws, l);
          pg8::Gemm g{WSP(const bf16, WS_H), w.wd1, M, D, FF}; pg8::StaticOrder S; S.init(M, D, C.G, C.bid); pg8::EpiF32 E{WSP(float, WS_Y), D};
          pg8::gemm_phase<pg8::EpiF32, pg8::StaticOrder, true, true>(C.lds + RING_OFF, g, S, E); }
        GRID_BAR();
        { const Ctx C = make_ctx(lds); const KArgs ka = kargs(); const float* modl = WSP(const float, WS_MOD) + (size_t)l * 2 * NMOD;
          t_post(C, ka->out, ka->out, WSP(const float, WS_Y), ka->in[6] + (size_t)(l * 3 + 2) * D, modl, 6, 0.5f, (l + 1 < DEPTH) ? ka->in[5] + (size_t)((l + 1) * 3) * D : nullptr, modl + 2 * NMOD, 0, WSP(bf16, WS_XN)); }
        GRID_BAR();
    }
}

extern "C" void kernel_launch(void* const* d_in, const int* in_sizes, int n_in, void* d_out, int out_size, void* d_ws, size_t ws_size, hipStream_t stream) {
    static int grid = 0;
    if (grid == 0) {
        if (n_in != 15 || in_sizes[0] != M * D || out_size != M * D || ws_size < WS_END) { fprintf(stderr, "kernel_launch: unexpected shapes (n_in %d, in0 %d, out %d, ws %zu)\n", n_in, n_in > 0 ? in_sizes[0] : -1, out_size, ws_size); grid = -1; return; }
        int dev = 0, cus = 0, per_cu = 0;
        if (hipGetDevice(&dev) != hipSuccess || hipDeviceGetAttribute(&cus, hipDeviceAttributeMultiprocessorCount, dev) != hipSuccess) { grid = -1; return; }
        if (hipFuncSetAttribute((const void*)trunk_fwd, hipFuncAttributeMaxDynamicSharedMemorySize, LDS_BYTES) != hipSuccess) { fprintf(stderr, "kernel_launch: hipFuncSetAttribute failed\n"); grid = -1; return; }
        if (hipOccupancyMaxActiveBlocksPerMultiprocessor(&per_cu, (const void*)trunk_fwd, NTHR, LDS_BYTES) != hipSuccess || per_cu < 1) { fprintf(stderr, "kernel_launch: occupancy query reports %d blocks per CU\n", per_cu); }
        (void)hipGetLastError();
        grid = cus;
    }
    if (grid < 0) return;
    if (hipMemsetAsync((char*)d_ws + WS_CTL, 0, CTL_ZERO_BYTES, stream) != hipSuccess) return;
    Args a{};
    for (int i = 0; i < 15; ++i) a.in[i] = (const float*)d_in[i];
    a.out = (float*)d_out; a.ws = (unsigned char*)d_ws;
    hipLaunchKernelGGL(trunk_fwd, dim3(grid), dim3(NTHR), LDS_BYTES, stream, a);
}
```

```cpp
#include <hip/hip_runtime.h>
#include <cstdio>
#include <cstdint>
namespace pg8 {
#define PG8_LAS __attribute__((address_space(3)))
typedef unsigned short bf16_t;
typedef short bf16x8 __attribute__((ext_vector_type(8)));
typedef float f32x4 __attribute__((ext_vector_type(4)));
typedef unsigned u32x4 __attribute__((ext_vector_type(4)));
constexpr int BM = 256, BK = 64, HALF = 128, HTB = HALF * BK * 2  , STAGE_BYTES = 8 * HTB, NXCD = 8, WGM = 8;

__host__ __device__ __forceinline__ int lds_byte(int r, int c) { const int st = (r >> 4) * 2 + (c >> 5), rr = r & 15, cc = c & 31, ob = rr * 64 + cc * 2; return st * 1024 + (ob ^ (((ob >> 9) & 1) << 5)); }
__host__ __device__ __forceinline__ void stage_rc(int b, int& R, int& C) { const int st = b / 1024, sb = b % 1024, swz = sb ^ (((sb >> 9) & 1) << 5); R = (st >> 1) * 16 + swz / 64; C = (st & 1) * 32 + (swz % 64) / 2; }
__host__ __device__ __forceinline__ int perm32(int rho) { const int n = rho >> 4, i = rho & 15; return 8 * (i >> 2) + 4 * n + (i & 3); }

struct Unit { int pm, pn; };
struct Gemm { const bf16_t* A; const bf16_t* Bt; int M, N, K; };

struct StaticOrder {
    int nM, nN, nwg, G, c;
    __host__ __device__ void init(int M, int N, int G_, int c_) { nM = M / BM; nN = N / BM; nwg = nM * nN; G = G_; c = c_; }
    __host__ __device__ bool next(int i, Unit& u) const {
        const long L = (long)i * G + c; if (L >= nwg) return false;
        int wgid = (int)L; { const int q = nwg / NXCD, r = nwg % NXCD, xcd = wgid % NXCD, off = wgid / NXCD; wgid = (xcd < r ? xcd * (q + 1) : r * (q + 1) + (xcd - r) * q) + off; }
        const int nig = WGM * nN, gid = wgid / nig, fm = gid * WGM, gsz = (nM - fm) < WGM ? (nM - fm) : WGM;
        u.pm = fm + ((wgid % nig) % gsz); u.pn = (wgid % nig) / gsz; return true;
    }
    __device__ __forceinline__ void a_ready(const Unit&) const {}
    __device__ __forceinline__ void done(const Unit&) const {}
};

__device__ __forceinline__ unsigned cvt_pk_bf16(float lo, float hi) { unsigned r; asm volatile("v_cvt_pk_bf16_f32 %0, %1, %2" : "=v"(r) : "v"(lo), "v"(hi)); return r; }
typedef float f32x2 __attribute__((ext_vector_type(2)));

struct EpiSwiGLU {
    static constexpr bool PERM = true, AFTER_DRAIN = false;
    bf16_t* H; int ldh;
    __device__ __forceinline__ void operator()(const f32x4 (&acc)[2][2][4][2], const Unit& u, int wr, int wc, int fr, int fq) const {
        const int row0 = u.pm * BM + wr * 64 + fr; const int col0 = u.pn * HALF + wc * 32 + 8 * fq;
#pragma unroll
        for (int ai = 0; ai < 2; ++ai)
#pragma unroll
            for (int m = 0; m < 4; ++m) { bf16_t* rowp = H + (size_t)(row0 + ai * HALF + m * 16) * ldh + col0;
                float h[8];
#pragma unroll
                for (int n = 0; n < 2; ++n)
#pragma unroll
                    for (int j = 0; j < 4; ++j) { const float g = acc[ai][0][m][n][j], up = acc[ai][1][m][n][j];
                        const float sg = __builtin_amdgcn_rcpf(1.0f + __builtin_amdgcn_exp2f(-1.4426950408889634f * g));
                        h[n * 4 + j] = g * sg * up; }
                u32x4 w; w.x = cvt_pk_bf16(h[0], h[1]); w.y = cvt_pk_bf16(h[2], h[3]); w.z = cvt_pk_bf16(h[4], h[5]); w.w = cvt_pk_bf16(h[6], h[7]);
                *(u32x4*)rowp = w; }
    }
};
struct EpiBf16Bias {
    static constexpr bool PERM = true, AFTER_DRAIN = false;
    bf16_t* O; int ldc; const float* bias;
    __device__ __forceinline__ void operator()(const f32x4 (&acc)[2][2][4][2], const Unit& u, int wr, int wc, int fr, int fq) const {
        const int row0 = u.pm * BM + wr * 64 + fr; const int col0 = u.pn * BM + wc * 32 + 8 * fq;
        f32x4 bv[2][2];
#pragma unroll
        for (int bj = 0; bj < 2; ++bj)
#pragma unroll
            for (int n = 0; n < 2; ++n) bv[bj][n] = *(const f32x4*)(bias + col0 + bj * HALF + 4 * n);
#pragma unroll
        for (int ai = 0; ai < 2; ++ai)
#pragma unroll
            for (int m = 0; m < 4; ++m) { bf16_t* rowp = O + (size_t)(row0 + ai * HALF + m * 16) * ldc + col0;
#pragma unroll
                for (int bj = 0; bj < 2; ++bj) { const f32x4 v0 = acc[ai][bj][m][0] + bv[bj][0], v1 = acc[ai][bj][m][1] + bv[bj][1];
                    u32x4 w; w.x = cvt_pk_bf16(v0[0], v0[1]); w.y = cvt_pk_bf16(v0[2], v0[3]); w.z = cvt_pk_bf16(v1[0], v1[1]); w.w = cvt_pk_bf16(v1[2], v1[3]);
                    *(u32x4*)(rowp + bj * HALF) = w; } }
    }
};
struct EpiF32 {
    static constexpr bool PERM = false, AFTER_DRAIN = false;
    float* Y; int ldc;
    __device__ __forceinline__ void operator()(const f32x4 (&acc)[2][2][4][2], const Unit& u, int wr, int wc, int fr, int fq) const {
        const int row0 = u.pm * BM + wr * 64 + fr; const int col0 = u.pn * BM + wc * 32 + 4 * fq;
#pragma unroll
        for (int ai = 0; ai < 2; ++ai)
#pragma unroll
            for (int m = 0; m < 4; ++m) { float* rowp = Y + (size_t)(row0 + ai * HALF + m * 16) * ldc + col0;
#pragma unroll
                for (int bj = 0; bj < 2; ++bj)
#pragma unroll
                    for (int n = 0; n < 2; ++n) *(f32x4*)(rowp + bj * HALF + n * 16) = acc[ai][bj][m][n]; }
    }
};

template <class Epi, class Sched, bool ALIGN_EPI = false, bool SP2 = false>
__device__ __forceinline__ void gemm_phase(PG8_LAS unsigned char* lds, const Gemm g, const Sched& S, const Epi& E) {
    int tid_ = threadIdx.x; asm volatile("" : "+v"(tid_));
    const int tid = tid_, wid = __builtin_amdgcn_readfirstlane(tid >> 6), lane = tid & 63, wr = wid >> 2, wc = wid & 3, fr = lane & 15, fq = lane >> 4;
    const int K = g.K, nt = K / BK;
    unsigned voffA[2], voffB[2];
#pragma unroll
    for (int i = 0; i < 2; ++i) { int R, C; stage_rc(tid * 16 + i * 8192, R, C); const int Rb = Epi::PERM ? ((R & ~31) + perm32(R & 31)) : R;
        voffA[i] = (unsigned)(R * K + C) * 2u; voffB[i] = (unsigned)(Rb * K + C) * 2u; }
    const size_t kstep = (size_t)(BK * 2);
    const size_t hstep = (size_t)HALF * K * 2;
    const size_t tstep = 2 * hstep;
    const unsigned ldsw = (unsigned)wid * 1024u;
    const int aoff = lds_byte(wr * 64 + fr, fq * 8), boff = lds_byte(wc * 32 + fr, fq * 8);
#define PG8_SA(b, h) (((b) * 2 + (h)) * HTB)
#define PG8_SB(b, h) ((4 + (b) * 2 + (h)) * HTB)
#define PG8_STAGE(bufoff, gbase, voff) do { _Pragma("unroll") for (int _i = 0; _i < 2; ++_i) \
        __builtin_amdgcn_global_load_lds((const unsigned*)((const char*)(gbase) + (voff)[_i]), (PG8_LAS unsigned*)(lds + (bufoff) + ldsw + _i * 8192), 16, 0, 0); } while (0)
#define PG8_LDA(dst, b, h) do { _Pragma("unroll") for (int m = 0; m < 4; ++m) _Pragma("unroll") for (int k = 0; k < 2; ++k) dst[m][k] = *(const PG8_LAS bf16x8*)(lds + PG8_SA(b, h) + aoff + m * 2048 + k * 1024); } while (0)
#define PG8_LDB(dst, b, h) do { _Pragma("unroll") for (int n = 0; n < 2; ++n) _Pragma("unroll") for (int k = 0; k < 2; ++k) dst[n][k] = *(const PG8_LAS bf16x8*)(lds + PG8_SB(b, h) + boff + n * 2048 + k * 1024); } while (0)
#define PG8_MMA(ai, bj, At, Bt) do { __builtin_amdgcn_s_setprio(1); _Pragma("unroll") for (int m = 0; m < 4; ++m) _Pragma("unroll") for (int n = 0; n < 2; ++n) _Pragma("unroll") for (int k = 0; k < 2; ++k) \
        acc[ai][bj][m][n] = __builtin_amdgcn_mfma_f32_16x16x32_bf16(Bt[n][k], At[m][k], acc[ai][bj][m][n], 0, 0, 0); __builtin_amdgcn_s_setprio(0); } while (0)
#define PG8_WAIT_V(n) asm volatile("s_waitcnt vmcnt(" #n ")" ::: "memory")
#define PG8_WAIT_L(n) asm volatile("s_waitcnt lgkmcnt(" #n ")" ::: "memory")
#define PG8_BAR __builtin_amdgcn_s_barrier()
#define PG8_SCHED __builtin_amdgcn_sched_barrier(0)
    Unit cur, nxt; int ui = 0;
    if (!S.next(0, cur)) return;
    f32x4 acc[2][2][4][2];
#pragma unroll
    for (int a = 0; a < 2; ++a)
#pragma unroll
        for (int b = 0; b < 2; ++b)
#pragma unroll
            for (int m = 0; m < 4; ++m)
#pragma unroll
                for (int n = 0; n < 2; ++n) acc[a][b][m][n] = (f32x4){0.f, 0.f, 0.f, 0.f};
    bf16x8 At[4][2], B0[2][2], B1[2][2];
    const char* cA = (const char*)g.A + (size_t)cur.pm * tstep; const char* cB = (const char*)g.Bt + (size_t)cur.pn * tstep;
    S.a_ready(cur);
    if constexpr (SP2) {
        PG8_STAGE(PG8_SB(0, 0), cB, voffB); PG8_STAGE(PG8_SB(0, 1), cB + hstep, voffB); PG8_STAGE(PG8_SA(0, 0), cA, voffA); PG8_STAGE(PG8_SA(0, 1), cA + hstep, voffA);
        if (wr == 1) PG8_BAR;
        PG8_WAIT_V(2); PG8_BAR;
        PG8_STAGE(PG8_SB(1, 0), cB + kstep, voffB); PG8_STAGE(PG8_SA(1, 0), cA + kstep, voffA); PG8_STAGE(PG8_SB(1, 1), cB + hstep + kstep, voffB);
        PG8_WAIT_V(6); PG8_BAR;
    } else {
        PG8_STAGE(PG8_SB(0, 0), cB, voffB); PG8_STAGE(PG8_SA(0, 0), cA, voffA); PG8_STAGE(PG8_SB(0, 1), cB + hstep, voffB); PG8_STAGE(PG8_SA(0, 1), cA + hstep, voffA);
        if (wr == 1) PG8_BAR;
        PG8_WAIT_V(4); PG8_BAR;
        PG8_STAGE(PG8_SB(1, 0), cB + kstep, voffB); PG8_STAGE(PG8_SA(1, 0), cA + kstep, voffA); PG8_STAGE(PG8_SB(1, 1), cB + hstep + kstep, voffB);
        PG8_WAIT_V(6); PG8_BAR;
    }
    for (;;) {
        const bool has_next = S.next(ui + 1, nxt);
        const char* nA = has_next ? (const char*)g.A + (size_t)nxt.pm * tstep : cA; const char* nB = has_next ? (const char*)g.Bt + (size_t)nxt.pn * tstep : cB;
        for (int t = 0; t < nt; t += 2) {
            const bool last = (t == nt - 2);
            const char* a1 = cA + (size_t)(t + 1) * kstep;
            const char* a2 = last ? nA : cA + (size_t)(t + 2) * kstep; const char* b2 = last ? nB : cB + (size_t)(t + 2) * kstep;
            const char* a3 = a2 + kstep; const char* b3 = b2 + kstep;
            if (last && has_next) S.a_ready(nxt);
            if constexpr (SP2) {
            PG8_LDB(B0, 0, 0); PG8_LDB(B1, 0, 1); PG8_SCHED; PG8_LDA(At, 0, 0); PG8_STAGE(PG8_SA(1, 1), a1 + hstep, voffA);
            PG8_WAIT_V(8); PG8_WAIT_L(0); PG8_BAR; PG8_MMA(0, 0, At, B0); PG8_MMA(0, 1, At, B1); PG8_BAR; PG8_SCHED;
            PG8_LDA(At, 0, 1); PG8_STAGE(PG8_SB(0, 0), b2, voffB); PG8_STAGE(PG8_SB(0, 1), b2 + hstep, voffB); PG8_STAGE(PG8_SA(0, 0), a2, voffA);
            PG8_WAIT_V(8); PG8_WAIT_L(0); PG8_BAR; PG8_MMA(1, 0, At, B0); PG8_MMA(1, 1, At, B1); PG8_BAR; PG8_SCHED;
            PG8_LDB(B0, 1, 0); PG8_LDB(B1, 1, 1); PG8_SCHED; PG8_LDA(At, 1, 0); PG8_STAGE(PG8_SA(0, 1), a2 + hstep, voffA);
            PG8_WAIT_V(8); PG8_WAIT_L(0); PG8_BAR; PG8_MMA(0, 0, At, B0); PG8_MMA(0, 1, At, B1); PG8_BAR; PG8_SCHED;
            PG8_LDA(At, 1, 1); PG8_STAGE(PG8_SB(1, 0), b3, voffB); PG8_STAGE(PG8_SB(1, 1), b3 + hstep, voffB); PG8_STAGE(PG8_SA(1, 0), a3, voffA);
            PG8_WAIT_V(8); PG8_WAIT_L(0); PG8_BAR; PG8_MMA(1, 0, At, B0); PG8_MMA(1, 1, At, B1); PG8_BAR; PG8_SCHED;
            } else {
            PG8_LDB(B0, 0, 0); PG8_SCHED; PG8_LDA(At, 0, 0); PG8_STAGE(PG8_SA(1, 1), a1 + hstep, voffA);
            PG8_WAIT_L(8); PG8_BAR; PG8_WAIT_L(0); PG8_MMA(0, 0, At, B0); PG8_BAR; PG8_SCHED;
            PG8_LDB(B1, 0, 1); PG8_STAGE(PG8_SB(0, 0), b2, voffB);
            PG8_BAR; PG8_WAIT_L(0); PG8_MMA(0, 1, At, B1); PG8_BAR;
            PG8_LDA(At, 0, 1); PG8_STAGE(PG8_SA(0, 0), a2, voffA);
            PG8_BAR; PG8_WAIT_L(0); PG8_MMA(1, 0, At, B0); PG8_BAR; PG8_SCHED;
            PG8_STAGE(PG8_SB(0, 1), b2 + hstep, voffB);
            PG8_WAIT_V(6); PG8_BAR; PG8_MMA(1, 1, At, B1); PG8_BAR;
            PG8_LDB(B0, 1, 0); PG8_SCHED; PG8_LDA(At, 1, 0); PG8_STAGE(PG8_SA(0, 1), a2 + hstep, voffA);
            PG8_WAIT_L(8); PG8_BAR; PG8_WAIT_L(0); PG8_MMA(0, 0, At, B0); PG8_BAR; PG8_SCHED;
            PG8_LDB(B1, 1, 1); PG8_STAGE(PG8_SB(1, 0), b3, voffB);
            PG8_BAR; PG8_WAIT_L(0); PG8_MMA(0, 1, At, B1); PG8_BAR;
            PG8_LDA(At, 1, 1); PG8_STAGE(PG8_SA(1, 0), a3, voffA);
            PG8_BAR; PG8_WAIT_L(0); PG8_MMA(1, 0, At, B0); PG8_BAR; PG8_SCHED;
            PG8_STAGE(PG8_SB(1, 1), b3 + hstep, voffB);
            PG8_WAIT_V(6); PG8_BAR; PG8_MMA(1, 1, At, B1); PG8_BAR;
            }
        }
        if constexpr (ALIGN_EPI) { if (wr == 0) PG8_BAR; }
        if constexpr (!Epi::AFTER_DRAIN) { E(acc, cur, wr, wc, fr, fq); S.done(cur); }
        if (!has_next) break;
#pragma unroll
        for (int a = 0; a < 2; ++a)
#pragma unroll
            for (int b = 0; b < 2; ++b)
#pragma unroll
                for (int m = 0; m < 4; ++m)
#pragma unroll
                    for (int n = 0; n < 2; ++n) acc[a][b][m][n] = (f32x4){0.f, 0.f, 0.f, 0.f};
        cur = nxt; cA = nA; cB = nB; ++ui;
        if constexpr (ALIGN_EPI) { if (wr == 1) PG8_BAR; }
    }
    PG8_WAIT_V(0);
    if constexpr (!ALIGN_EPI) { if (wr == 0) PG8_BAR; }
    PG8_BAR;
    if constexpr (Epi::AFTER_DRAIN) { E.fused(acc, cur, wr, wc, fr, fq, lds, wid, lane); S.done(cur); }
#undef PG8_SA
#undef PG8_SB
#undef PG8_STAGE
#undef PG8_LDA
#undef PG8_LDB
#undef PG8_MMA
#undef PG8_WAIT_V
#undef PG8_WAIT_L
#undef PG8_BAR
#undef PG8_SCHED
}
}
#define GAS __attribute__((address_space(1)))
#define LAS __attribute__((address_space(3)))
typedef unsigned short bf16;
typedef unsigned v4u __attribute__((ext_vector_type(4)));
typedef float f32x4 __attribute__((ext_vector_type(4)));
typedef short bf16x8 __attribute__((ext_vector_type(8)));
typedef GAS unsigned gu32;
typedef GAS unsigned long long gu64;
#define RLX_AGENT __ATOMIC_RELAXED, __HIP_MEMORY_SCOPE_AGENT
#define LDS_WAIT() asm volatile("s_waitcnt lgkmcnt(0)" ::: "memory")
#define VM_WAIT() asm volatile("s_waitcnt vmcnt(0)" ::: "memory")
__device__ __forceinline__ unsigned long long rt() { return __builtin_amdgcn_s_memrealtime(); }
__device__ __forceinline__ unsigned f2bf(float f) { unsigned u = __builtin_bit_cast(unsigned, f); return (u + 0x7fffu + ((u >> 16) & 1u)) >> 16; }
__device__ __forceinline__ unsigned pk2(float lo, float hi) { return f2bf(lo) | (f2bf(hi) << 16); }

#define XB_TMO      128
#define XB_XCNT(j)  (256  + 64 * (j))
#define XB_XSUB(j)  (1280 + 64 * (j))
#define XB_XGEN(j)  (2304 + 64 * (j))
#define XB_TOP      3328
#define XB_TOPGEN   3392
#define XCD_BAR_WORDS 3456
#define XB_SPIN_CAP (1u << 18)

__device__ __forceinline__ unsigned xb_ld(unsigned* p)              { return __hip_atomic_load(p, __ATOMIC_RELAXED, __HIP_MEMORY_SCOPE_AGENT); }
__device__ __forceinline__ unsigned xb_add(unsigned* p, unsigned v) { return __hip_atomic_fetch_add(p, v, __ATOMIC_RELAXED, __HIP_MEMORY_SCOPE_AGENT); }
__device__ __forceinline__ unsigned xb_xcc_id() { return (unsigned)__builtin_amdgcn_s_getreg((3 << 11) | 20) & 0xFu; }
#define XB_SPIN(cond, bar) do { unsigned _sp = 0; while (cond) { __builtin_amdgcn_s_sleep(1); \
    if ((++_sp & 255u) == 0u) { if (xb_ld(&(bar)[XB_TMO])) break; if (_sp > XB_SPIN_CAP) { atomicAdd(&(bar)[XB_TMO], 1u); break; } } } } while (0)

struct XcdBarrier {
    unsigned* bar; unsigned x;
    volatile LAS unsigned* st;
};

__device__ __forceinline__ XcdBarrier xcd_barrier_post(unsigned* bar, volatile LAS unsigned* st) {
    XcdBarrier b; b.bar = bar; b.x = xb_xcc_id(); b.st = st;
    if (threadIdx.x == 0) (void)xb_add(&bar[XB_XCNT(b.x)], 1u);
    return b;
}
__device__ __forceinline__ void xcd_barrier_complete(unsigned* bar, unsigned x, unsigned& nloc, unsigned& nx) {
    const unsigned G = gridDim.x * gridDim.y * gridDim.z;
    unsigned sum, cnt, mine, sp = 0u;
    for (;;) {
        sum = 0u; cnt = 0u; mine = 0u;
#pragma unroll
        for (unsigned j = 0; j < 16; ++j) { const unsigned c = xb_ld(&bar[XB_XCNT(j)]); sum += c; cnt += (c > 0u) ? 1u : 0u; mine = (j == x) ? c : mine; }
        if (sum == G) break;
        __builtin_amdgcn_s_sleep(1);
        if ((++sp & 255u) == 0u) { if (xb_ld(&bar[XB_TMO])) break; if (sp > XB_SPIN_CAP) { atomicAdd(&bar[XB_TMO], 1u); break; } }
    }
    nloc = mine > 0u ? mine : 1u; nx = cnt > 0u ? cnt : 1u;
}

__device__ __forceinline__ void xcd_barrier(const XcdBarrier& b) {
    asm volatile("s_waitcnt vmcnt(0)" ::: "memory");
    __syncthreads();
    if (threadIdx.x == 0) {
        unsigned* bar = b.bar;
        __builtin_amdgcn_s_waitcnt(0);
        unsigned nloc = b.st[0], nx = b.st[1];
        if (nloc == 0u) { xcd_barrier_complete(bar, b.x, nloc, nx); b.st[0] = nloc; b.st[1] = nx; }
        const unsigned old = xb_add(&bar[XB_XSUB(b.x)], 1u);
        const unsigned gen = old / nloc;
        if (old + 1u == (gen + 1u) * nloc) {
            __builtin_amdgcn_fence(__ATOMIC_RELEASE, "agent");
            asm volatile("s_waitcnt vmcnt(0)" ::: "memory");
            const unsigned og = xb_add(&bar[XB_TOP], 1u);
            const unsigned tg = og / nx;
            if (og + 1u == (tg + 1u) * nx) xb_add(&bar[XB_TOPGEN], 1u);
            else XB_SPIN(xb_ld(&bar[XB_TOPGEN]) == tg, bar);
            __builtin_amdgcn_fence(__ATOMIC_ACQUIRE, "agent");
            xb_add(&bar[XB_XGEN(b.x)], 1u);
            asm volatile("s_waitcnt vmcnt(0)" ::: "memory");
        } else {
            XB_SPIN(xb_ld(&bar[XB_XGEN(b.x)]) == gen, bar);
            __builtin_amdgcn_fence(__ATOMIC_ACQUIRE, "agent");
            asm volatile("s_waitcnt vmcnt(0)" ::: "memory");
        }
    }
    __syncthreads();
}

constexpr int NWAVES = 8, NTHR = NWAVES * 64;
constexpr int BATCH = 2, SEQ = 8192, D = 1024, M = BATCH * SEQ, DEPTH = 4, FF = 2816, NGU = 2 * FF, INC = 2304, NMOD = 9 * D;
constexpr int QA_OFF = 0, KA_OFF = 512, VA_OFF = 640, QB_OFF = 768, KB_OFF = 1280, VB_OFF = 1792;
constexpr float EPS = 1e-6f;
constexpr size_t MiB = 1u << 20;
constexpr size_t WS_CTL = 0, CTL_ZERO_BYTES = 1 * MiB;
constexpr size_t WS_MODP = 2 * MiB;
constexpr size_t WS_MOD = 8 * MiB;
constexpr size_t WS_KMEAN = 9 * MiB;
constexpr size_t WS_W = 16 * MiB;
constexpr size_t W_GU = (size_t)NGU * D * 2, W_D = (size_t)D * FF * 2, W_IN = (size_t)INC * D * 2, W_OUT = (size_t)D * D * 2;
constexpr size_t W_LAYER = 2 * W_GU + 2 * W_D + W_IN + W_OUT;
constexpr size_t WS_XN = 176 * MiB;
constexpr size_t WS_H = 208 * MiB;
constexpr size_t WS_Y = 296 * MiB;
constexpr size_t WS_QKV = 360 * MiB;
constexpr size_t WS_O = 432 * MiB;
constexpr size_t WS_DUMMY = 464 * MiB, WS_END = 528 * MiB;
constexpr size_t WS_PO = 208 * MiB, WS_PML = 336 * MiB, WS_SEL = 340 * MiB;
static_assert(WS_PO == WS_H && WS_SEL + (size_t)16 * SEQ * 4 <= WS_QKV, "attention scratch overlay");
static_assert(WS_W + DEPTH * W_LAYER <= WS_XN && WS_H + (size_t)M * FF * 2 <= WS_Y && WS_QKV + (size_t)M * INC * 2 <= WS_O, "d_ws map");
constexpr int CW_BAR = 4096;
constexpr int RING_OFF = 0, RING_BYTES = 131072;
constexpr int LDSCTL_OFF = RING_BYTES, MISC_OFF = LDSCTL_OFF + 320;
constexpr int CACT_OFF = RING_BYTES + 1024;
constexpr int LDS_BYTES = 147456;
static_assert(CACT_OFF + 8192 <= LDS_BYTES, "LDS map");

typedef unsigned long long u64;
typedef unsigned u32x2 __attribute__((ext_vector_type(2)));
__device__ __forceinline__ float bflo(unsigned w) { return __uint_as_float(w << 16); }
__device__ __forceinline__ float bfhi(unsigned w) { return __uint_as_float(w & 0xffff0000u); }
__device__ __forceinline__ void unpack8(const v4u w, float (&f)[8]) { f[0] = bflo(w.x); f[1] = bfhi(w.x); f[2] = bflo(w.y); f[3] = bfhi(w.y); f[4] = bflo(w.z); f[5] = bfhi(w.z); f[6] = bflo(w.w); f[7] = bfhi(w.w); }
__device__ __forceinline__ float wave_sum(float v) {
#pragma unroll
    for (int o = 1; o < 64; o <<= 1) v += __shfl_xor(v, o);
    return v;
}
__device__ const unsigned char T5B[129] = {
    0, 1, 2, 3, 4, 5, 6, 7, 8, 9, 10, 11, 12, 13, 14, 15, 16, 16, 16, 17, 17, 18, 18, 18, 19, 19, 19, 20, 20, 20, 20, 21, 21, 21, 21, 22, 22, 22, 22, 22, 23, 23, 23, 23, 23, 23, 24, 24, 24, 24, 24, 24,
    25, 25, 25, 25, 25, 25, 25, 26, 26, 26, 26, 26, 26, 26, 26, 27, 27, 27, 27, 27, 27, 27, 27, 27, 27, 28, 28, 28, 28, 28, 28, 28, 28, 28, 28, 29, 29, 29, 29, 29, 29, 29, 29, 29, 29, 29, 29,
    30, 30, 30, 30, 30, 30, 30, 30, 30, 30, 30, 30, 30, 30, 31, 31, 31, 31, 31, 31, 31, 31, 31, 31, 31, 31, 31, 31, 31, 31};

struct Args { const float* in[15]; float* out; unsigned char* ws; };
typedef const __attribute__((address_space(4))) Args* KArgs;
__device__ __forceinline__ KArgs kargs() { unsigned long long p = (unsigned long long)__builtin_amdgcn_kernarg_segment_ptr(); asm volatile("" : "+s"(p)); return (KArgs)p; }

struct Ctx { LAS unsigned char* lds; int tid, lane, wave, G, vcu, bid; };
__device__ __forceinline__ Ctx make_ctx(unsigned char* lds) {
    Ctx C; C.lds = (LAS unsigned char*)lds; int t = threadIdx.x; asm volatile("" : "+v"(t)); C.tid = t; C.lane = t & 63; C.wave = __builtin_amdgcn_readfirstlane(t >> 6);
    int g = gridDim.x, bx = blockIdx.x; asm volatile("" : "+s"(g), "+s"(bx)); C.G = g; C.bid = bx; C.vcu = (g % 8 == 0) ? (bx % 8) * (g / 8) + bx / 8 : bx; return C;
}

__device__ __forceinline__ void p0_transpose_item(const float* W, int K, int N, bf16* WT, int rowmap, LAS float* scr, int item, int lane) {
    const int nblk = N / 32, kb = item / nblk, nb = item % nblk, k0 = 64 * kb, n0 = 32 * nb;
    const int r0 = rowmap == 0 ? n0 : (256 * (n0 >> 7) + (n0 & 127) + (rowmap == 2 ? 128 : 0));
#pragma unroll 8
    for (int i = 0; i < 32; ++i) { const int kk = 2 * i + (lane >> 5); scr[kk * 33 + (lane & 31)] = W[(size_t)(k0 + kk) * N + n0 + (lane & 31)]; }
    LDS_WAIT(); asm volatile("" ::: "memory");
    const int c = lane & 7;
#pragma unroll
    for (int j = 0; j < 4; ++j) { const int n = (lane >> 3) + 8 * j; const LAS float* s = scr + (8 * c) * 33 + n;
        v4u o; o.x = pk2(s[0 * 33], s[1 * 33]); o.y = pk2(s[2 * 33], s[3 * 33]); o.z = pk2(s[4 * 33], s[5 * 33]); o.w = pk2(s[6 * 33], s[7 * 33]);
        *(GAS v4u*)(WT + (size_t)(r0 + n) * K + k0 + 8 * c) = o; }
    LDS_WAIT(); asm volatile("" ::: "memory");
}
__device__ __forceinline__ void p0_prologue(const Ctx& C) {
    const KArgs ka = kargs();
    LAS float* scr = (LAS float*)(C.lds + RING_OFF + C.wave * 16384);
    LAS float* cact = (LAS float*)(C.lds + CACT_OFF);
    for (int i = C.tid; i < 2 * D; i += NTHR) { const float v = ka->in[1][i]; cact[i] = v / (1.0f + __expf(-v)); }
    __syncthreads();
    const int gw = C.vcu * NWAVES + C.wave, NGW = C.G * NWAVES;
    { float* modp = (float*)(ka->ws + WS_MODP);
      for (int u = gw; u < DEPTH * 36 * 16; u += NGW) {
        const int l = u / 576, rem = u % 576, cg = rem / 16, kc = rem % 16;
        const float* Wp = ka->in[3] + ((size_t)l * D + kc * 64) * NMOD + cg * 256 + 4 * C.lane;
        f32x4 a0 = {0.f, 0.f, 0.f, 0.f}, a1 = {0.f, 0.f, 0.f, 0.f};
#pragma unroll 8
        for (int k = 0; k < 64; ++k) { const f32x4 w = *(const GAS f32x4*)(Wp + (size_t)k * NMOD); const float c0 = cact[kc * 64 + k], c1 = cact[D + kc * 64 + k]; a0 += w * c0; a1 += w * c1; }
        *(GAS f32x4*)(modp + ((size_t)((l * 16 + kc) * 2 + 0)) * NMOD + cg * 256 + 4 * C.lane) = a0;
        *(GAS f32x4*)(modp + ((size_t)((l * 16 + kc) * 2 + 1)) * NMOD + cg * 256 + 4 * C.lane) = a1;
      } }
    constexpr int I_G = (D / 64) * (FF / 32), I_D = (FF / 64) * (D / 32), I_IN = (D / 64) * (INC / 32), I_OUT = (D / 64) * (D / 32);
    constexpr int I_LAYER = 4 * I_G + 2 * I_D + I_IN + I_OUT;
    for (int it = gw; it < DEPTH * I_LAYER; it += NGW) {
        const int l = it / I_LAYER; int r = it % I_LAYER;
        bf16* wl = (bf16*)(ka->ws + WS_W + (size_t)l * W_LAYER);
        bf16* wgu0 = wl; bf16* wd0 = (bf16*)((unsigned char*)wl + W_GU); bf16* wgu1 = (bf16*)((unsigned char*)wl + W_GU + W_D); bf16* wd1 = (bf16*)((unsigned char*)wl + 2 * W_GU + W_D);
        bf16* win = (bf16*)((unsigned char*)wl + 2 * W_GU + 2 * W_D); bf16* wout = (bf16*)((unsigned char*)wl + 2 * W_GU + 2 * W_D + W_IN);
        const float* g0 = ka->in[7] + (size_t)(l * 2) * D * FF; const float* u0 = ka->in[8] + (size_t)(l * 2) * D * FF; const float* d0 = ka->in[9] + (size_t)(l * 2) * FF * D;
        if (r < I_G) { p0_transpose_item(g0, D, FF, wgu0, 1, scr, r, C.lane); continue; } r -= I_G;
        if (r < I_G) { p0_transpose_item(u0, D, FF, wgu0, 2, scr, r, C.lane); continue; } r -= I_G;
        if (r < I_D) { p0_transpose_item(d0, FF, D, wd0, 0, scr, r, C.lane); continue; } r -= I_D;
        if (r < I_G) { p0_transpose_item(g0 + (size_t)D * FF, D, FF, wgu1, 1, scr, r, C.lane); continue; } r -= I_G;
        if (r < I_G) { p0_transpose_item(u0 + (size_t)D * FF, D, FF, wgu1, 2, scr, r, C.lane); continue; } r -= I_G;
        if (r < I_D) { p0_transpose_item(d0 + (size_t)FF * D, FF, D, wd1, 0, scr, r, C.lane); continue; } r -= I_D;
        if (r < I_IN) { p0_transpose_item(ka->in[10] + (size_t)l * D * INC, D, INC, win, 0, scr, r, C.lane); continue; } r -= I_IN;
        p0_transpose_item(ka->in[12] + (size_t)l * D * D, D, D, wout, 0, scr, r, C.lane);
    }
}
__device__ __forceinline__ void p0_mod_final(const Ctx& C) {
    const KArgs ka = kargs();
    const float* modp = (const float*)(ka->ws + WS_MODP); float* mod = (float*)(ka->ws + WS_MOD);
    for (int gt = C.vcu * NTHR + C.tid; gt < DEPTH * 2 * NMOD; gt += C.G * NTHR) {
        const int l = gt / (2 * NMOD), rem = gt % (2 * NMOD), b = rem / NMOD, n = rem % NMOD;
        float s = ka->in[4][l * NMOD + n];
#pragma unroll
        for (int kc = 0; kc < 16; ++kc) s += modp[((size_t)((l * 16 + kc) * 2 + b)) * NMOD + n];
        mod[gt] = s;
    }
}
__device__ __forceinline__ void load_row(const float* p, int lane, f32x4 (&v)[4]) {
#pragma unroll
    for (int j = 0; j < 4; ++j) v[j] = *(const GAS f32x4*)(p + 4 * lane + 256 * j);
}
__device__ __forceinline__ void norm_mod_store(const f32x4 (&x)[4], const float* g, const float* sc, const float* sh, bf16* xn, int lane) {
    float ss = 0.f;
#pragma unroll
    for (int j = 0; j < 4; ++j) ss += (x[j].x * x[j].x + x[j].y * x[j].y) + (x[j].z * x[j].z + x[j].w * x[j].w);
    const float rstd = 1.0f / sqrtf(wave_sum(ss) * (1.0f / D) + EPS);
#pragma unroll
    for (int j = 0; j < 4; ++j) { const int c = 4 * lane + 256 * j;
        const f32x4 gg = *(const GAS f32x4*)(g + c), s1 = *(const GAS f32x4*)(sc + c), s0 = *(const GAS f32x4*)(sh + c);
        const f32x4 h = x[j] * rstd * gg * (s1 + 1.0f) + s0;
        u32x2 w; w.x = pk2(h.x, h.y); w.y = pk2(h.z, h.w);
        *(GAS u32x2*)(xn + c) = w; }
}
__device__ __forceinline__ void t_pre(const Ctx& C, const float* x, const float* gpre, const float* modl  , int chunk0, bf16* XN) {
    const int gw = C.vcu * NWAVES + C.wave, NGW = C.G * NWAVES;
    for (int m = gw; m < M; m += NGW) { const int b = m >> 13; f32x4 v[4]; load_row(x + (size_t)m * D, C.lane, v);
        const float* mb = modl + (size_t)b * NMOD + chunk0 * D;
        norm_mod_store(v, gpre, mb + D, mb, XN + (size_t)m * D, C.lane); }
}
__device__ __forceinline__ void t_post(const Ctx& C, const float* xsrc, float* xdst, const float* Y, const float* gpost, const float* modl, int chunk0, float coef,
                                       const float* gpre_next, const float* modn, int chunkn, bf16* XN) {
    const int gw = C.vcu * NWAVES + C.wave, NGW = C.G * NWAVES;
    for (int m = gw; m < M; m += NGW) { const int b = m >> 13; f32x4 y[4], x[4]; load_row(Y + (size_t)m * D, C.lane, y); load_row(xsrc + (size_t)m * D, C.lane, x);
        float ss = 0.f;
#pragma unroll
        for (int j = 0; j < 4; ++j) ss += (y[j].x * y[j].x + y[j].y * y[j].y) + (y[j].z * y[j].z + y[j].w * y[j].w);
        const float rstd = 1.0f / sqrtf(wave_sum(ss) * (1.0f / D) + EPS);
        const float* gate = modl + (size_t)b * NMOD + (chunk0 + 2) * D;
#pragma unroll
        for (int j = 0; j < 4; ++j) { const int c = 4 * C.lane + 256 * j;
            const f32x4 gp = *(const GAS f32x4*)(gpost + c), gt = *(const GAS f32x4*)(gate + c);
            x[j] = x[j] + (y[j] * rstd * gp) * gt * coef;
            *(GAS f32x4*)(xdst + (size_t)m * D + c) = x[j]; }
        if (gpre_next) { const float* mb = modn + (size_t)b * NMOD + chunkn * D; norm_mod_store(x, gpre_next, mb + D, mb, XN + (size_t)m * D, C.lane); }
    }
}
__device__ __forceinline__ void t_groupnorm(const Ctx& C, bf16* O, const float* gg) {
    const int gw = C.vcu * NWAVES + C.wave, NGW = C.G * NWAVES;
    for (int m = gw; m < M; m += NGW) { bf16* row = O + (size_t)m * D + 16 * C.lane;
        const v4u w0 = *(const GAS v4u*)row, w1 = *(const GAS v4u*)(row + 8); float f[16];
        { float t[8]; unpack8(w0, t);
#pragma unroll
          for (int i = 0; i < 8; ++i) f[i] = t[i];
          unpack8(w1, t);
#pragma unroll
          for (int i = 0; i < 8; ++i) f[8 + i] = t[i]; }
        float ss = 0.f;
#pragma unroll
        for (int i = 0; i < 16; ++i) ss += f[i] * f[i];
#pragma unroll
        for (int o = 1; o < 32; o <<= 1) ss += __shfl_xor(ss, o);
        const float rstd = 1.0f / sqrtf(ss * (1.0f / 512.0f) + EPS);
        const float* g = gg + 16 * C.lane;
#pragma unroll
        for (int i = 0; i < 16; ++i) f[i] = f[i] * rstd * g[i];
        v4u o0, o1; o0.x = pk2(f[0], f[1]); o0.y = pk2(f[2], f[3]); o0.z = pk2(f[4], f[5]); o0.w = pk2(f[6], f[7]); o1.x = pk2(f[8], f[9]); o1.y = pk2(f[10], f[11]); o1.z = pk2(f[12], f[13]); o1.w = pk2(f[14], f[15]);
        *(GAS v4u*)row = o0; *(GAS v4u*)(row + 8) = o1; }
}
__device__ __forceinline__ void a_kmean(const Ctx& C, const bf16* QKV, float* kmean) {
    const int gw = C.vcu * NWAVES + C.wave, NGW = C.G * NWAVES, r8 = C.lane >> 3, sub = C.lane & 7;
    for (int u = gw; u < 2 * 8 * 32; u += NGW) { const int b = u >> 8, h = (u >> 5) & 7, n = u & 31;
        const bf16* Kp = QKV + ((size_t)b * SEQ + 256 * n + r8) * INC + KB_OFF + h * 64 + sub * 8;
        float acc[8];
#pragma unroll
        for (int i = 0; i < 8; ++i) acc[i] = 0.f;
#pragma unroll 4
        for (int it = 0; it < 32; ++it) { const v4u w = *(const GAS v4u*)(Kp + (size_t)it * 8 * INC); float f[8]; unpack8(w, f);
#pragma unroll
            for (int i = 0; i < 8; ++i) acc[i] += f[i]; }
#pragma unroll
        for (int i = 0; i < 8; ++i) { float v = acc[i]; v += __shfl_xor(v, 8); v += __shfl_xor(v, 16); v += __shfl_xor(v, 32); acc[i] = v * (1.0f / 256.0f); }
        if (r8 == 0) { float* o = kmean + (size_t)u * 64 + sub * 8;
            *(GAS f32x4*)o = (f32x4){acc[0], acc[1], acc[2], acc[3]}; *(GAS f32x4*)(o + 4) = (f32x4){acc[4], acc[5], acc[6], acc[7]}; }
    }
}
struct PairAcc { float m, l, o[8]; };
__device__ __forceinline__ void pair_attend(PairAcc& A, const float (&q)[8], const bf16* Kp, const bf16* Vp, int nk, int dist0, const LAS float* tbl) {
    for (int j = 0; j < nk; ++j) {
        const v4u kw = *(const GAS v4u*)(Kp + (size_t)j * INC); const v4u vw = *(const GAS v4u*)(Vp + (size_t)j * INC);
        float kf[8], vf[8]; unpack8(kw, kf); unpack8(vw, vf);
        float s = 0.f;
#pragma unroll
        for (int i = 0; i < 8; ++i) s += q[i] * kf[i];
        s += __shfl_xor(s, 1); s += __shfl_xor(s, 2); s += __shfl_xor(s, 4);
        const int dist = dist0 - j; s += tbl[dist < 128 ? dist : 128];
        const float mn = fmaxf(A.m, s), sc = __expf(A.m - mn), p = __expf(s - mn);
        A.l = A.l * sc + p;
#pragma unroll
        for (int i = 0; i < 8; ++i) A.o[i] = A.o[i] * sc + p * vf[i];
        A.m = mn;
    }
}
__device__ __forceinline__ void store_o8(bf16* p, const float (&o)[8], float inv) {
    v4u w; w.x = pk2(o[0] * inv, o[1] * inv); w.y = pk2(o[2] * inv, o[3] * inv); w.z = pk2(o[4] * inv, o[5] * inv); w.w = pk2(o[6] * inv, o[7] * inv);
    *(GAS v4u*)p = w;
}
__device__ __forceinline__ void moba_scalar_unit(const Ctx& C, int u, const bf16* QKV, const float* kmean, const float* rel_bias, bf16* O) {
    LAS float* tbl = (LAS float*)(C.lds + RING_OFF); LAS float* km = (LAS float*)(C.lds + RING_OFF + 1024); LAS int* selb = (LAS int*)(C.lds + RING_OFF + 1024 + 8192) + C.wave * 64;
    const int gi = C.lane >> 3, sub = C.lane & 7;
    {
            const int b = u >> 9, h = (u >> 6) & 7, ci = u & 63, cur = ci >> 1;
            if (C.tid <= 128) tbl[C.tid] = rel_bias[T5B[C.tid] * 16 + 8 + h];
            for (int i = C.tid; i < 32 * 64; i += NTHR) km[i] = kmean[(size_t)((b * 8 + h) * 32) * 64 + i];
            __syncthreads();
            const size_t rowb = (size_t)b * SEQ; const int qw0 = ci * 128 + C.wave * 16;
            { const int ql = C.lane >> 2, part = C.lane & 3; const bf16* qp = QKV + (rowb + qw0 + ql) * INC + QB_OFF + h * 64;
              float g[8];
#pragma unroll
              for (int t = 0; t < 8; ++t) g[t] = 0.f;
#pragma unroll
              for (int c = 0; c < 8; ++c) { const v4u w = *(const GAS v4u*)(qp + 8 * c); float qf[8]; unpack8(w, qf);
#pragma unroll
                  for (int t = 0; t < 8; ++t) { const LAS float* kr = km + (part + 4 * t) * 64 + 8 * c;
#pragma unroll
                      for (int i = 0; i < 8; ++i) g[t] += qf[i] * kr[i]; } }
#pragma unroll
              for (int t = 0; t < 8; ++t) if (part + 4 * t >= cur) g[t] = -INFINITY;
#pragma unroll
              for (int r = 0; r < 3; ++r) { float bv = -INFINITY; int bi = 1000;
#pragma unroll
                  for (int t = 0; t < 8; ++t) if (g[t] > bv) { bv = g[t]; bi = part + 4 * t; }
#pragma unroll
                  for (int off = 1; off <= 2; off <<= 1) { const float ov = __shfl_xor(bv, off); const int oi = __shfl_xor(bi, off); if (ov > bv || (ov == bv && oi < bi)) { bv = ov; bi = oi; } }
                  if (part == 0) selb[ql * 4 + r] = (bv > -INFINITY) ? bi : -1;
#pragma unroll
                  for (int t = 0; t < 8; ++t) if (part + 4 * t == bi) g[t] = -INFINITY; } }
            LDS_WAIT(); __syncthreads();
            const int slot = gi & 3;
            for (int qq = 0; qq < 8; ++qq) { const int ql = 2 * qq + (gi >> 2), i = qw0 + ql;
                const bf16* qp = QKV + (rowb + i) * INC + QB_OFF + h * 64 + sub * 8; float q[8]; { const v4u w = *(const GAS v4u*)qp; unpack8(w, q); }
#pragma unroll
                for (int t = 0; t < 8; ++t) q[t] *= 0.125f;
                int n, nk, dist0;
                if (slot < 3) { n = selb[ql * 4 + slot]; nk = n >= 0 ? 256 : 0; if (n < 0) n = 0; dist0 = i - 256 * n; }
                else { n = cur; nk = i - 256 * cur + 1; dist0 = i - 256 * cur; }
                const bf16* Kp = QKV + (rowb + 256 * n) * INC + KB_OFF + h * 64 + sub * 8; const bf16* Vp = Kp + (VB_OFF - KB_OFF);
                PairAcc A; A.m = -INFINITY; A.l = 0.f;
#pragma unroll
                for (int t = 0; t < 8; ++t) A.o[t] = 0.f;
                pair_attend(A, q, Kp, Vp, nk, dist0, tbl);
                float mx = A.m; mx = fmaxf(mx, __shfl_xor(mx, 8)); mx = fmaxf(mx, __shfl_xor(mx, 16));
                const float f = (A.m == -INFINITY) ? 0.f : __expf(A.m - mx);
                float L = A.l * f; L += __shfl_xor(L, 8); L += __shfl_xor(L, 16);
                float o[8];
#pragma unroll
                for (int t = 0; t < 8; ++t) { float v = A.o[t] * f; v += __shfl_xor(v, 8); v += __shfl_xor(v, 16); o[t] = v; }
                if (slot == 0) store_o8(O + (rowb + i) * D + 512 + h * 64 + sub * 8, o, 1.0f / L);
            }
            }
}
__device__ __forceinline__ void swa_scalar_unit(const Ctx& C, int u, const bf16* QKV, const float* rel_bias, const float* sinks, bf16* O) {
    LAS float* tbl = (LAS float*)(C.lds + RING_OFF);
    const int gi = C.lane >> 3, sub = C.lane & 7;
    {
            const int v = u, b = v >> 9, hq = (v >> 6) & 7, ci = v & 63, kvh = hq >> 2;
            if (C.tid <= 128) tbl[C.tid] = rel_bias[T5B[C.tid] * 16 + hq];
            __syncthreads();
            const size_t rowb = (size_t)b * SEQ; const int qw0 = ci * 128 + C.wave * 16; const float sink = sinks[hq];
            for (int qq = 0; qq < 2; ++qq) { const int ql = 8 * qq + gi, i = qw0 + ql;
                const bf16* qp = QKV + (rowb + i) * INC + QA_OFF + hq * 64 + sub * 8; float q[8]; { const v4u w = *(const GAS v4u*)qp; unpack8(w, q); }
#pragma unroll
                for (int t = 0; t < 8; ++t) q[t] *= 0.125f;
                const int klo = i >= 127 ? i - 127 : 0, nk = i - klo + 1, dist0 = i - klo;
                const bf16* Kp = QKV + (rowb + klo) * INC + KA_OFF + kvh * 64 + sub * 8; const bf16* Vp = Kp + (VA_OFF - KA_OFF);
                PairAcc A; A.m = -INFINITY; A.l = 0.f;
#pragma unroll
                for (int t = 0; t < 8; ++t) A.o[t] = 0.f;
                pair_attend(A, q, Kp, Vp, nk, dist0, tbl);
                const float mx = fmaxf(A.m, sink), f = __expf(A.m - mx), L = A.l * f + __expf(sink - mx);
                store_o8(O + (rowb + i) * D + hq * 64 + sub * 8, A.o, f / L);
            }
    }
}
namespace at {
typedef short bf16x8 __attribute__((ext_vector_type(8)));
typedef short s16x4 __attribute__((ext_vector_type(4)));
typedef float f32x16 __attribute__((ext_vector_type(16)));
typedef float f32x2_t __attribute__((ext_vector_type(2))); typedef __bf16 bf16x2_t __attribute__((ext_vector_type(2)));
constexpr float LOG2E = 1.4426950408889634f, C2 = 0.125f * LOG2E, NEGB = -1.0e30f;
constexpr int SLOTB = 8192;
constexpr int RT = 320;
constexpr int L_K = 0, L_V = 4 * SLOTB, L_TBL = 8 * SLOTB, L_WSF = L_TBL + 4 * RT * 4, L_KM = L_WSF + 8 * 64 * 4, L_CNT = L_KM + 32 * 64 * 4, L_LIST = L_CNT + 64, L_END = L_LIST + 16384;
static_assert(L_END <= RING_BYTES, "attention LDS map");
__device__ __forceinline__ int crow(int r, int hi) { return (r & 3) + 8 * (r >> 2) + 4 * hi; }
__device__ __forceinline__ unsigned cvtpk(float lo, float hi) { f32x2_t v = {lo, hi}; bf16x2_t b = __builtin_convertvector(v, bf16x2_t); return __builtin_bit_cast(unsigned, b); }
#define AT_SBAR() __builtin_amdgcn_sched_barrier(0)
__device__ __forceinline__ void qkt(f32x16& p0, f32x16& p1, const LAS char* Kslot, const bf16x8 (&qr)[4], int r32, int hi) {
    const LAS char* kb = Kslot + hi * 1024 + r32 * 16;
    f32x16 z;
#pragma unroll
    for (int i = 0; i < 16; ++i) z[i] = 0.f;
#pragma unroll
    for (int d0 = 0; d0 < 4; ++d0) {
        const bf16x8 b0 = *(const LAS bf16x8*)(kb + d0 * 2048);
        const bf16x8 b1 = *(const LAS bf16x8*)(kb + d0 * 2048 + 512);
        if (d0 == 0) { p0 = __builtin_amdgcn_mfma_f32_32x32x16_bf16(b0, qr[0], z, 0, 0, 0); p1 = __builtin_amdgcn_mfma_f32_32x32x16_bf16(b1, qr[0], z, 0, 0, 0); }
        else { p0 = __builtin_amdgcn_mfma_f32_32x32x16_bf16(b0, qr[d0], p0, 0, 0, 0); p1 = __builtin_amdgcn_mfma_f32_32x32x16_bf16(b1, qr[d0], p1, 0, 0, 0); } }
}
__device__ __forceinline__ void pv(f32x16 (&o)[2], int vb, bf16x8 pa0, bf16x8 pa1, bf16x8 pa2, bf16x8 pa3) {
#pragma unroll
    for (int d0 = 0; d0 < 2; ++d0) { s16x4 lo[4], hi[4];
#pragma unroll
        for (int ks = 0; ks < 4; ++ks) {
            asm volatile("ds_read_b64_tr_b16 %0,%1 offset:%c2" : "=&v"(lo[ks]) : "v"(vb), "i"(d0 * 4096 + ks * 1024) : "memory");
            asm volatile("ds_read_b64_tr_b16 %0,%1 offset:%c2" : "=&v"(hi[ks]) : "v"(vb), "i"(d0 * 4096 + ks * 1024 + 512) : "memory"); }
        asm volatile("s_waitcnt lgkmcnt(0)" ::: "memory"); AT_SBAR();
#define AT_PK(k) (bf16x8){lo[k][0], lo[k][1], lo[k][2], lo[k][3], hi[k][0], hi[k][1], hi[k][2], hi[k][3]}
        o[d0] = __builtin_amdgcn_mfma_f32_32x32x16_bf16(pa0, AT_PK(0), o[d0], 0, 0, 0);
        o[d0] = __builtin_amdgcn_mfma_f32_32x32x16_bf16(pa1, AT_PK(1), o[d0], 0, 0, 0);
        o[d0] = __builtin_amdgcn_mfma_f32_32x32x16_bf16(pa2, AT_PK(2), o[d0], 0, 0, 0);
        o[d0] = __builtin_amdgcn_mfma_f32_32x32x16_bf16(pa3, AT_PK(3), o[d0], 0, 0, 0);
#undef AT_PK
    }
}
__device__ __forceinline__ int vbase(int lane, int hi) { return ((lane >> 4) & 1) * 32 + (lane & 3) * 8 + (4 * hi + ((lane & 15) >> 2)) * 64; }
__device__ __forceinline__ void scale_o(f32x16 (&o)[2], LAS float* wsf, float f, int r32, int hi) {
    if (hi == 0) wsf[r32] = f;
    asm volatile("s_waitcnt lgkmcnt(0)" ::: "memory");
#pragma unroll
    for (int r = 0; r < 16; ++r) { const float g = wsf[crow(r, hi)]; o[0][r] *= g; o[1][r] *= g; }
    asm volatile("s_waitcnt lgkmcnt(0)" ::: "memory");
}
__device__ __forceinline__ float rtab(const float* rel_bias, int col, int i, bool swa) { const int d = 255 - i; return d < 0 ? NEGB : (d < 128 ? rel_bias[T5B[d] * 16 + col] * LOG2E : (swa ? NEGB : rel_bias[31 * 16 + col] * LOG2E)); }
__device__ __forceinline__ void tile_finish(const f32x16& s0, const f32x16& s1, float alpha, float rs, float& l, f32x16 (&o)[2], int vb, LAS float* wsf, int r32, int hi) {
    l = l * alpha + rs;
    if (__any(alpha != 1.0f)) scale_o(o, wsf, alpha, r32, hi);
    v4u w0, w1, w2, w3;
    w0.x = cvtpk(s0[0], s0[1]); w0.y = cvtpk(s0[2], s0[3]); w0.z = cvtpk(s0[4], s0[5]); w0.w = cvtpk(s0[6], s0[7]);
    w1.x = cvtpk(s0[8], s0[9]); w1.y = cvtpk(s0[10], s0[11]); w1.z = cvtpk(s0[12], s0[13]); w1.w = cvtpk(s0[14], s0[15]);
    w2.x = cvtpk(s1[0], s1[1]); w2.y = cvtpk(s1[2], s1[3]); w2.z = cvtpk(s1[4], s1[5]); w2.w = cvtpk(s1[6], s1[7]);
    w3.x = cvtpk(s1[8], s1[9]); w3.y = cvtpk(s1[10], s1[11]); w3.z = cvtpk(s1[12], s1[13]); w3.w = cvtpk(s1[14], s1[15]);
    AT_SBAR();
    pv(o, vb, __builtin_bit_cast(bf16x8, w0), __builtin_bit_cast(bf16x8, w1), __builtin_bit_cast(bf16x8, w2), __builtin_bit_cast(bf16x8, w3));
}
__device__ __forceinline__ void tile_near(f32x16& s0, f32x16& s1, const LAS float* Rl, float& m, float& l, f32x16 (&o)[2], int vb, LAS float* wsf, int r32, int hi) {
#pragma unroll
    for (int r = 0; r < 16; ++r) { const int c = (r & 3) + 8 * (r >> 2); s0[r] = s0[r] * C2 + Rl[c]; s1[r] = s1[r] * C2 + Rl[c + 32]; }
    float mt = fmaxf(s0[0], s1[0]);
#pragma unroll
    for (int r = 1; r < 16; ++r) mt = fmaxf(mt, fmaxf(s0[r], s1[r]));
    mt = fmaxf(mt, __shfl_xor(mt, 32));
    const float mn = fmaxf(m, mt), alpha = __builtin_amdgcn_exp2f(m - mn);
    float rs = 0.f;
#pragma unroll
    for (int r = 0; r < 16; ++r) { s0[r] = __builtin_amdgcn_exp2f(s0[r] - mn); s1[r] = __builtin_amdgcn_exp2f(s1[r] - mn); rs += s0[r] + s1[r]; }
    m = mn;
    tile_finish(s0, s1, alpha, rs, l, o, vb, wsf, r32, hi);
}
__device__ __forceinline__ void tile_far(f32x16& s0, f32x16& s1, float bc, float& m, float& l, f32x16 (&o)[2], int vb, LAS float* wsf, int r32, int hi) {
    float mt = fmaxf(s0[0], s1[0]);
#pragma unroll
    for (int r = 1; r < 16; ++r) mt = fmaxf(mt, fmaxf(s0[r], s1[r]));
    mt = fmaxf(mt, __shfl_xor(mt, 32));
    const float mn = fmaxf(m, mt * C2 + bc), alpha = __builtin_amdgcn_exp2f(m - mn), off = bc - mn;
    float rs = 0.f;
#pragma unroll
    for (int r = 0; r < 16; ++r) { s0[r] = __builtin_amdgcn_exp2f(s0[r] * C2 + off); s1[r] = __builtin_amdgcn_exp2f(s1[r] * C2 + off); rs += s0[r] + s1[r]; }
    m = mn;
    tile_finish(s0, s1, alpha, rs, l, o, vb, wsf, r32, hi);
}
__device__ __forceinline__ void stage_kv(LAS char* lds, const bf16* Kg, const bf16* Vg, int t0, int t1, int tid) {
    const int key = tid >> 3, c = tid & 7;
    const int kd = L_K + c * 1024 + key * 16, vd = L_V + ((c >> 2) * 4 + (key >> 4)) * 1024 + (key & 15) * 64 + (c & 3) * 16;
    v4u kw[4], vw[4];
#pragma unroll
    for (int t = 0; t < 4; ++t) if (t >= t0 && t < t1) { kw[t] = *(const GAS v4u*)(Kg + (ptrdiff_t)(64 * t + key) * INC + 8 * c); vw[t] = *(const GAS v4u*)(Vg + (ptrdiff_t)(64 * t + key) * INC + 8 * c); }
#pragma unroll
    for (int t = 0; t < 4; ++t) if (t >= t0 && t < t1) { *(LAS v4u*)(lds + kd + t * SLOTB) = kw[t]; *(LAS v4u*)(lds + vd + t * SLOTB) = vw[t]; }
}
__device__ __forceinline__ void load_q(bf16x8 (&qr)[4], const bf16* qrow, int hi) {
#pragma unroll
    for (int d0 = 0; d0 < 4; ++d0) qr[d0] = *(const GAS bf16x8*)(qrow + 16 * d0 + 8 * hi);
}
__device__ __forceinline__ void zero_o(f32x16 (&o)[2]) {
#pragma unroll
    for (int i = 0; i < 16; ++i) { o[0][i] = 0.f; o[1][i] = 0.f; }
}

__device__ __forceinline__ void swa_unit(const Ctx& C, int u, const bf16* QKV, const float* rel_bias, const float* sinks, bf16* O) {
    const int b = u >> 7, kvh = (u >> 6) & 1, blk = u & 63, r32 = C.lane & 31, hi = C.lane >> 5;
    LAS char* lds = (LAS char*)C.lds; LAS float* tbl = (LAS float*)(lds + L_TBL); LAS float* wsf = (LAS float*)(lds + L_WSF) + C.wave * 64;
    for (int i = C.tid; i < 4 * RT; i += NTHR) { const int g = i / RT; tbl[i] = rtab(rel_bias, kvh * 4 + g, i % RT, true); }
    const size_t rowb = (size_t)b * SEQ;
    const bf16* Kg = QKV + ((ptrdiff_t)rowb + 128 * (blk - 1)) * INC + KA_OFF + kvh * 64;
    stage_kv(lds, Kg, Kg + (VA_OFF - KA_OFF), blk == 0 ? 2 : 0, 4, C.tid);
    asm volatile("s_waitcnt lgkmcnt(0)" ::: "memory"); __syncthreads();
    const int vb = (int)(unsigned)(uintptr_t)(lds + L_V) + vbase(C.lane, hi);
    for (int qi = 0; qi < 2; ++qi) { const int ti = 2 * C.wave + qi, g = ti >> 2, t = ti & 3, hq = kvh * 4 + g;
        bf16x8 qr[4]; load_q(qr, QKV + (rowb + 128 * blk + 32 * t + r32) * INC + QA_OFF + hq * 64, hi);
        float m = NEGB, l = 0.f; f32x16 o[2]; zero_o(o);
        const LAS float* tg = tbl + g * RT + 255 - (128 + 32 * t + r32 - 4 * hi);
        int jlo = t < 2 ? 0 : 1; const int jhi = jlo + 3; if (blk == 0 && jlo < 2) jlo = 2;
#pragma unroll 1
        for (int j = jlo; j < jhi; ++j) { f32x16 s0, s1; qkt(s0, s1, lds + L_K + j * SLOTB, qr, r32, hi);
            tile_near(s0, s1, tg + 64 * j, m, l, o, vb + j * SLOTB, wsf, r32, hi); }
        l += __shfl_xor(l, 32);
        const float den = l + __builtin_amdgcn_exp2f(sinks[hq] * LOG2E - m);
        scale_o(o, wsf, 1.0f / den, r32, hi);
        bf16* Ob = O + (rowb + 128 * blk + 32 * t) * D + hq * 64 + r32;
#pragma unroll
        for (int r = 0; r < 16; ++r) { bf16* p = Ob + (size_t)crow(r, hi) * D; p[0] = (bf16)f2bf(o[0][r]); p[32] = (bf16)f2bf(o[1][r]); }
    }
}
}

namespace at {
__device__ __forceinline__ void moba_own_unit(const Ctx& C, int bh, int cur, const bf16* QKV, const float* kmean, const float* rel_bias, unsigned* sel, float* Po, float* Pml) {
    const int b = bh >> 3, h = bh & 7, r32 = C.lane & 31, hi = C.lane >> 5;
    LAS char* lds = (LAS char*)C.lds; LAS float* tbl = (LAS float*)(lds + L_TBL); LAS float* wsf = (LAS float*)(lds + L_WSF) + C.wave * 64; LAS float* km = (LAS float*)(lds + L_KM);
    if (C.tid < RT) tbl[C.tid] = rtab(rel_bias, 8 + h, C.tid, false);
    for (int i = C.tid; i < 32 * 64; i += NTHR) km[i] = kmean[(size_t)bh * 2048 + i];
    const size_t rowb = (size_t)b * SEQ;
    const bf16* Kg = QKV + (rowb + 256 * cur) * INC + KB_OFF + h * 64;
    stage_kv(lds, Kg, Kg + (VB_OFF - KB_OFF), 0, 4, C.tid);
    asm volatile("s_waitcnt lgkmcnt(0)" ::: "memory"); __syncthreads();
    for (int pass = 0; pass < 2; ++pass) { const int ql = C.lane >> 2, part = C.lane & 3, q = 256 * cur + pass * 128 + C.wave * 16 + ql; const bf16* qp = QKV + (rowb + q) * INC + QB_OFF + h * 64;
        float g[8];
#pragma unroll
        for (int t = 0; t < 8; ++t) g[t] = 0.f;
#pragma unroll 1
        for (int c = 0; c < 8; ++c) { const v4u w = *(const GAS v4u*)(qp + 8 * c); float qf[8]; unpack8(w, qf);
#pragma unroll
            for (int t = 0; t < 8; ++t) { const LAS float* kr = km + (part + 4 * t) * 64 + 8 * c;
#pragma unroll
                for (int i = 0; i < 8; ++i) g[t] += qf[i] * kr[i]; } }
#pragma unroll
        for (int t = 0; t < 8; ++t) if (part + 4 * t >= cur) g[t] = -INFINITY;
        unsigned word = 0u;
#pragma unroll
        for (int r = 0; r < 3; ++r) { float bv = -INFINITY; int bi = 1000;
#pragma unroll
            for (int t = 0; t < 8; ++t) if (g[t] > bv) { bv = g[t]; bi = part + 4 * t; }
#pragma unroll
            for (int off = 1; off <= 2; off <<= 1) { const float ov = __shfl_xor(bv, off); const int oi = __shfl_xor(bi, off); if (ov > bv || (ov == bv && oi < bi)) { bv = ov; bi = oi; } }
            word |= ((bv > -INFINITY) ? (unsigned)bi : 255u) << (8 * r);
#pragma unroll
            for (int t = 0; t < 8; ++t) if (part + 4 * t == bi) g[t] = -INFINITY; }
        if (part == 0) sel[(size_t)bh * SEQ + q] = word; }
    const int vb = (int)(unsigned)(uintptr_t)(lds + L_V) + vbase(C.lane, hi);
    const int q0 = 256 * cur + 32 * C.wave, qrel = 32 * C.wave + r32;
    bf16x8 qr[4]; load_q(qr, QKV + (rowb + q0 + r32) * INC + QB_OFF + h * 64, hi);
    float m = NEGB, l = 0.f; f32x16 o[2]; zero_o(o);
    const LAS float* tg = tbl + 255 - (qrel - 4 * hi); const float b31 = tbl[0];
#pragma unroll 1
    for (int j = 0; j <= (C.wave >> 1); ++j) { f32x16 s0, s1; qkt(s0, s1, lds + L_K + j * SLOTB, qr, r32, hi);
        if (32 * C.wave - 64 * j - 63 >= 128) tile_far(s0, s1, b31, m, l, o, vb + j * SLOTB, wsf, r32, hi);
        else tile_near(s0, s1, tg + 64 * j, m, l, o, vb + j * SLOTB, wsf, r32, hi); }
    l += __shfl_xor(l, 32);
    float* pob = Po + (((size_t)bh * SEQ + q0) * 4 + 3) * 64 + r32;
#pragma unroll
    for (int r = 0; r < 16; ++r) { float* p = pob + (size_t)crow(r, hi) * 256; p[0] = o[0][r]; p[32] = o[1][r]; }
    if (hi == 0) { float* p = Pml + (((size_t)bh * SEQ + q0 + r32) * 4 + 3) * 2; *(GAS f32x2_t*)p = (f32x2_t){m, l}; }
}
__device__ __forceinline__ void moba_gather_item(const Ctx& C, int bh, int n, int c0, int c1, const bf16* QKV, const float* rel_bias, const unsigned* sel, float* Po, float* Pml) {
    const int b = bh >> 3, h = bh & 7, r32 = C.lane & 31, hi = C.lane >> 5;
    LAS char* lds = (LAS char*)C.lds; LAS float* tbl = (LAS float*)(lds + L_TBL); LAS float* wsf = (LAS float*)(lds + L_WSF) + C.wave * 64;
    LAS unsigned* cnt = (LAS unsigned*)(lds + L_CNT); LAS unsigned short* list = (LAS unsigned short*)(lds + L_LIST);
    if (C.tid < RT) tbl[C.tid] = rtab(rel_bias, 8 + h, C.tid, false);
    const size_t rowb = (size_t)b * SEQ;
    const bf16* Kg = QKV + (rowb + 256 * n) * INC + KB_OFF + h * 64;
    stage_kv(lds, Kg, Kg + (VB_OFF - KB_OFF), 0, 4, C.tid);
    const unsigned* selp = sel + (size_t)bh * SEQ; const int nch = 4 * (c1 - c0);
    int myc = 0;
    for (int ch = C.wave; ch < nch; ch += NWAVES) { const unsigned w = selp[256 * c0 + 64 * ch + C.lane];
        const bool mt = ((w & 255u) == (unsigned)n) || (((w >> 8) & 255u) == (unsigned)n) || (((w >> 16) & 255u) == (unsigned)n);
        myc += __popcll(__ballot(mt)); }
    if (C.lane == 0) cnt[C.wave] = (unsigned)myc;
    asm volatile("s_waitcnt lgkmcnt(0)" ::: "memory"); __syncthreads();
    int base = 0, total = 0;
#pragma unroll
    for (int w = 0; w < NWAVES; ++w) { const int c = (int)cnt[w]; if (w < C.wave) base += c; total += c; }
    { int pos = base;
      for (int ch = C.wave; ch < nch; ch += NWAVES) { const int q = 256 * c0 + 64 * ch + C.lane; const unsigned w = selp[q];
        const int sl = ((w & 255u) == (unsigned)n) ? 0 : (((w >> 8) & 255u) == (unsigned)n) ? 1 : (((w >> 16) & 255u) == (unsigned)n) ? 2 : -1;
        const unsigned long long mask = __ballot(sl >= 0);
        if (sl >= 0) list[pos + __popcll(mask & ((1ull << C.lane) - 1ull))] = (unsigned short)((q << 2) | sl);
        pos += __popcll(mask); } }
    asm volatile("s_waitcnt lgkmcnt(0)" ::: "memory"); __syncthreads();
    const int vb = (int)(unsigned)(uintptr_t)(lds + L_V) + vbase(C.lane, hi);
    const int ntile = (total + 31) >> 5;
    for (int tile = C.wave; tile < ntile; tile += NWAVES) {
        const int idx = 32 * tile + r32; const unsigned e = list[idx < total ? idx : total - 1]; const int q = (int)(e >> 2);
        bf16x8 qr[4]; load_q(qr, QKV + (rowb + q) * INC + QB_OFF + h * 64, hi);
        float m = NEGB, l = 0.f; f32x16 o[2]; zero_o(o);
        const int dq = q - 256 * n; const float b31 = tbl[0];
#pragma unroll 1
        for (int j = 0; j < 4; ++j) { f32x16 s0, s1; qkt(s0, s1, lds + L_K + j * SLOTB, qr, r32, hi);
            const int bd = dq - 64 * j;
            if (__any(bd - 63 < 128)) { const int bc = bd - 4 * hi; tile_near(s0, s1, tbl + 255 - (bc < 255 ? bc : 255), m, l, o, vb + j * SLOTB, wsf, r32, hi); }
            else tile_far(s0, s1, b31, m, l, o, vb + j * SLOTB, wsf, r32, hi); }
        l += __shfl_xor(l, 32);
#pragma unroll
        for (int r = 0; r < 16; ++r) { const int ri = 32 * tile + crow(r, hi);
            if (ri < total) { const unsigned e2 = list[ri]; float* p = Po + (((size_t)bh * SEQ + (e2 >> 2)) * 4 + (e2 & 3u)) * 64 + r32; p[0] = o[0][r]; p[32] = o[1][r]; } }
        if (hi == 0 && idx < total) { float* p = Pml + (((size_t)bh * SEQ + q) * 4 + (e & 3u)) * 2; *(GAS f32x2_t*)p = (f32x2_t){m, l}; }
    }
}
}
__device__ __forceinline__ void t_merge_norm(const Ctx& C, const unsigned* sel, const float* Po, const float* Pml, const bf16* O, bf16* Oout, const float* gg) {
    const int gw = C.vcu * NWAVES + C.wave, NGW = C.G * NWAVES, h = C.lane >> 3, dsub = C.lane & 7;
    for (int m = gw; m < M; m += NGW) { const int b = m >> 13, q = m & (SEQ - 1); const size_t pi = ((size_t)(b * 8 + h) * SEQ + q);
        const unsigned w = sel[pi];
        float ms[4], ls[4]; bool ok[4];
#pragma unroll
        for (int s = 0; s < 4; ++s) { ok[s] = (s == 3) || (((w >> (8 * s)) & 255u) != 255u); const at::f32x2_t ml = *(const GAS at::f32x2_t*)(Pml + (pi * 4 + s) * 2); ms[s] = ok[s] ? ml.x : -INFINITY; ls[s] = ok[s] ? ml.y : 0.f; }
        const float mx = fmaxf(fmaxf(ms[0], ms[1]), fmaxf(ms[2], ms[3]));
        float acc[8], L = 0.f;
#pragma unroll
        for (int i = 0; i < 8; ++i) acc[i] = 0.f;
#pragma unroll
        for (int s = 0; s < 4; ++s) { const float f = ok[s] ? __builtin_amdgcn_exp2f(ms[s] - mx) : 0.f; L += f * ls[s];
            const float* p = Po + (pi * 4 + s) * 64 + 8 * dsub; const f32x4 a0 = *(const GAS f32x4*)p, a1 = *(const GAS f32x4*)(p + 4);
            if (ok[s]) { acc[0] += f * a0.x; acc[1] += f * a0.y; acc[2] += f * a0.z; acc[3] += f * a0.w; acc[4] += f * a1.x; acc[5] += f * a1.y; acc[6] += f * a1.z; acc[7] += f * a1.w; } }
        const float inv = 1.0f / L; float ssb = 0.f;
#pragma unroll
        for (int i = 0; i < 8; ++i) { acc[i] *= inv; ssb += acc[i] * acc[i]; }
        const bf16* rin = O + (size_t)m * D + 8 * C.lane; bf16* row = Oout + (size_t)m * D + 8 * C.lane;
        float a[8]; { const v4u wa = *(const GAS v4u*)rin; unpack8(wa, a); }
        float ssa = 0.f;
#pragma unroll
        for (int i = 0; i < 8; ++i) ssa += a[i] * a[i];
        const float ra = 1.0f / sqrtf(wave_sum(ssa) * (1.0f / 512.0f) + EPS), rb = 1.0f / sqrtf(wave_sum(ssb) * (1.0f / 512.0f) + EPS);
        const float* ga = gg + 8 * C.lane; const float* gb = gg + 512 + 8 * C.lane;
        v4u oa, ob;
        oa.x = pk2(a[0] * ra * ga[0], a[1] * ra * ga[1]); oa.y = pk2(a[2] * ra * ga[2], a[3] * ra * ga[3]); oa.z = pk2(a[4] * ra * ga[4], a[5] * ra * ga[5]); oa.w = pk2(a[6] * ra * ga[6], a[7] * ra * ga[7]);
        ob.x = pk2(acc[0] * rb * gb[0], acc[1] * rb * gb[1]); ob.y = pk2(acc[2] * rb * gb[2], acc[3] * rb * gb[3]); ob.z = pk2(acc[4] * rb * gb[4], acc[5] * rb * gb[5]); ob.w = pk2(acc[6] * rb * gb[6], acc[7] * rb * gb[7]);
        *(GAS v4u*)row = oa; *(GAS v4u*)(row + 512) = ob; }
}
#ifndef ATTN_MODE
#define ATTN_MODE 2
#endif
constexpr int PB_NI = 75;
__device__ const unsigned PB_FLAT[PB_NI] = {196864,328448,525568,788480,1182720,1774080,2104064,262657,394241,591361,919809,1379841,2102529,328450,525570,788482,1248258,1905410,2104578,394243,656899,1051139,1642499,2103555,525572,788484,1182724,1774084,2104068,656901,1051141,1642501,2103557,722694,1116934,1642758,2103558,854023,1379591,2102535,919816,1445384,2102792,985609,1511177,2103049,1051402,1511434,2103050,1313803,2102283,1379596,2102540,1445389,2102797,1445646,2102798,1511439,2103055,1577232,2103312,2101777,2102034,2102291,2102548,2102805,2103062,2103319,2103576,2103833,2104090,2104347,2104604,2104861,2105118};
__device__ const unsigned PB_ORDER[2 * PB_NI] = {50397184,386861312,370085376,538510848,538640384,67240192,386861313,370085377,538515456,538641408,50397185,151388416,420546048,538510080,538581248,67240193,151388417,420546049,538510592,538581249,538054912,100925697,454164481,538447873,538510849,538054913,100926209,454165505,538449665,538515457,84082688,285935104,454164480,538382081,538910208,84083200,285935105,454165504,538383873,538910209,84082689,100925696,353239296,538447872,538510081,84083201,100926208,353239297,538449664,538510593,168166144,420479744,302776320,538382080,538641409,168166656,420480256,302777344,538383872,538647041,168166145,420479745,302776321,538380545,538712832,168166657,420480257,302777345,538380801,538712833,538120704,235471105,252315904,403771392,538771968,538120705,235472897,252315905,403771393,538778624,336333568,235471104,201851393,538380544,538647040,336333569,235472896,201851905,538380800,538640385,218629888,370018305,538247425,538316288,218629889,370019585,538248961,538318080,134545408,185009664,201851904,386927105,134545920,185009665,201850881,386928385,134546432,319554048,201850880,386927104,538771969,134545409,319554049,201851392,386928384,538778625,134545921,370018304,538250240,538314752,538844416,134546433,370019584,538252288,538316032,538844417,353175296,538184448,487784960,538314753,353176576,538186496,487784961,538316033,353175297,538184449,538247424,269158912,353176577,538186497,538248960,269158913,269091584,269091585,538250241,538316289,269092096,269092097,538252289,538318081};
__device__ const unsigned short PB_OFFS[33] = {0,5,10,15,20,25,30,35,40,45,50,55,60,65,70,75,80,85,90,94,98,102,106,111,116,121,126,130,134,138,142,146,150};

__device__ __forceinline__ void a_attention(const Ctx& C, const bf16* QKV, const float* kmean, const float* rel_bias, const float* sinks, bf16* O, unsigned* sel, float* Po, float* Pml) {
#if ATTN_MODE == 0
    for (int u = C.vcu; u < 2048; u += C.G) { __syncthreads(); if (u < 1024) moba_scalar_unit(C, u, QKV, kmean, rel_bias, O); else swa_scalar_unit(C, u - 1024, QKV, rel_bias, sinks, O); }
#elif ATTN_MODE == 1
    for (int u = C.vcu; u < 1024 + 256; u += C.G) { __syncthreads(); if (u < 1024) moba_scalar_unit(C, u, QKV, kmean, rel_bias, O); else at::swa_unit(C, u - 1024, QKV, rel_bias, sinks, O); }
#else
    for (int k = 0;; ++k) { int kind, a0, a1 = 0;
        if (C.G == 256) { if (k >= 3) break; if (k < 2) { kind = 0; a0 = 2 * (C.vcu >> 5) + k; a1 = C.vcu & 31; } else { kind = 1; a0 = C.vcu; } }
        else { const int u = C.vcu + k * C.G; if (u >= 512 + 256) break; if (u < 512) { kind = 0; a0 = u >> 5; a1 = u & 31; } else { kind = 1; a0 = u - 512; } }
        __syncthreads();
        if (kind == 0) at::moba_own_unit(C, a0, a1, QKV, kmean, rel_bias, sel, Po, Pml); else at::swa_unit(C, a0, QKV, rel_bias, sinks, O); }
#endif
}
__device__ __forceinline__ void a_gather(const Ctx& C, const bf16* QKV, const float* rel_bias, const unsigned* sel, float* Po, float* Pml) {
    const bool tab = (C.G == 256); const int x = C.vcu >> 5, c = C.vcu & 31;
    const int k0 = tab ? (int)PB_OFFS[c] : C.vcu, k1 = tab ? (int)PB_OFFS[c + 1] : 16 * PB_NI, dk = tab ? 1 : C.G;
    for (int k = k0; k < k1; k += dk) { int bh, n, c0, c1;
        if (tab) { const unsigned it = PB_ORDER[k]; bh = 2 * x + (int)(it & 1u); n = (int)((it >> 8) & 255u); c0 = (int)((it >> 16) & 255u); c1 = (int)(it >> 24); }
        else { const unsigned it = PB_FLAT[k % PB_NI]; bh = k / PB_NI; n = (int)(it & 255u); c0 = (int)((it >> 8) & 255u); c1 = (int)((it >> 16) & 255u); }
        __syncthreads(); at::moba_gather_item(C, bh, n, c0, c1, QKV, rel_bias, sel, Po, Pml); }
}
struct LayerW { const bf16 *wgu0, *wd0, *wgu1, *wd1, *win, *wout; };
__device__ __forceinline__ LayerW layer_w(const unsigned char* ws, int l) {
    const unsigned char* wl = ws + WS_W + (size_t)l * W_LAYER; LayerW w;
    w.wgu0 = (const bf16*)wl; w.wd0 = (const bf16*)(wl + W_GU); w.wgu1 = (const bf16*)(wl + W_GU + W_D); w.wd1 = (const bf16*)(wl + 2 * W_GU + W_D);
    w.win = (const bf16*)(wl + 2 * W_GU + 2 * W_D); w.wout = (const bf16*)(wl + 2 * W_GU + 2 * W_D + W_IN); return w;
}
__global__ void __launch_bounds__(NTHR, 2) trunk_fwd(Args args_unused) {
    extern __shared__ __attribute__((aligned(16))) unsigned char lds[];
    { const Ctx C = make_ctx(lds);
    for (int u = C.tid; u < (LDS_BYTES - LDSCTL_OFF) / 4; u += NTHR) ((LAS unsigned*)(C.lds + LDSCTL_OFF))[u] = 0u;
    __syncthreads();
    { const Ctx C = make_ctx(lds); const KArgs ka = kargs(); (void)xcd_barrier_post((unsigned*)((gu32*)(ka->ws + WS_CTL) + CW_BAR), (volatile LAS unsigned*)(C.lds + MISC_OFF) + 8); } }
#define GRID_BAR() do { const KArgs ka_ = kargs(); XcdBarrier b_; b_.bar = (unsigned*)((gu32*)(ka_->ws + WS_CTL) + CW_BAR); b_.x = xb_xcc_id(); b_.st = (volatile LAS unsigned*)((LAS unsigned char*)lds + MISC_OFF) + 8; xcd_barrier(b_); } while (0)
#define WSP(T, off) ((T*)(ka->ws + (off)))
#ifndef RP_G
#define RP_G 1
#endif
#ifndef RP_A
#define RP_A 1
#endif
#ifndef RP_M
#define RP_M 1
#endif
#ifndef RP_T
#define RP_T 1
#endif
#define REP(n) for (int rep_ = 0; rep_ < (n); ++rep_)

    { const Ctx C = make_ctx(lds); p0_prologue(C); } GRID_BAR();
    { const Ctx C = make_ctx(lds); p0_mod_final(C); } GRID_BAR();
    { const Ctx C = make_ctx(lds); const KArgs ka = kargs(); t_pre(C, ka->in[0], ka->in[5], WSP(const float, WS_MOD), 0, WSP(bf16, WS_XN)); }
    GRID_BAR();

    for (int l = 0; l < DEPTH; ++l) {
        REP(RP_G) {
        { const Ctx C = make_ctx(lds); const KArgs ka = kargs(); const LayerW w = layer_w(ka->ws, l);
          pg8::Gemm g{WSP(const bf16, WS_XN), w.wgu0, M, NGU, D}; pg8::StaticOrder S; S.init(M, NGU, C.G, C.bid); pg8::EpiSwiGLU E{WSP(bf16, WS_H), FF};
          pg8::gemm_phase<pg8::EpiSwiGLU, pg8::StaticOrder, true, true>(C.lds + RING_OFF, g, S, E); }
        GRID_BAR();
        }
        REP(RP_G) {
        { const Ctx C = make_ctx(lds); const KArgs ka = kargs(); const LayerW w = layer_w(ka->ws, l);
          pg8::Gemm g{WSP(const bf16, WS_H), w.wd0, M, D, FF}; pg8::StaticOrder S; S.init(M, D, C.G, C.bid); pg8::EpiF32 E{WSP(float, WS_Y), D};
          pg8::gemm_phase<pg8::EpiF32, pg8::StaticOrder, true, true>(C.lds + RING_OFF, g, S, E); }
        GRID_BAR();
        }
        REP(RP_T) {
        { const Ctx C = make_ctx(lds); const KArgs ka = kargs(); const float* modl = WSP(const float, WS_MOD) + (size_t)l * 2 * NMOD;
          t_post(C, l == 0 ? ka->in[0] : (const float*)ka->out, (rep_ + 1 < RP_T) ? WSP(float, WS_DUMMY) : ka->out, WSP(const float, WS_Y), ka->in[6] + (size_t)(l * 3 + 0) * D, modl, 0, 0.5f, ka->in[5] + (size_t)(l * 3 + 1) * D, modl, 3, WSP(bf16, WS_XN)); }
        GRID_BAR();
        }
        REP(RP_G) {
        { const Ctx C = make_ctx(lds); const KArgs ka = kargs(); const LayerW w = layer_w(ka->ws, l);
          pg8::Gemm g{WSP(const bf16, WS_XN), w.win, M, INC, D}; pg8::StaticOrder S; S.init(M, INC, C.G, C.bid); pg8::EpiBf16Bias E{WSP(bf16, WS_QKV), INC, ka->in[11] + (size_t)l * INC};
          pg8::gemm_phase<pg8::EpiBf16Bias, pg8::StaticOrder, true, true>(C.lds + RING_OFF, g, S, E); }
        GRID_BAR();
        }
        REP(RP_A) {
        { const Ctx C = make_ctx(lds); const KArgs ka = kargs(); a_kmean(C, WSP(const bf16, WS_QKV), WSP(float, WS_KMEAN)); }
        GRID_BAR();
        }
        REP(RP_A) {
        { const Ctx C = make_ctx(lds); const KArgs ka = kargs(); a_attention(C, WSP(const bf16, WS_QKV), WSP(const float, WS_KMEAN), ka->in[2], ka->in[13] + l * 8, WSP(bf16, WS_O), WSP(unsigned, WS_SEL), WSP(float, WS_PO), WSP(float, WS_PML)); }
        GRID_BAR();
        }
#if ATTN_MODE == 2
        REP(RP_A) {
        { const Ctx C = make_ctx(lds); const KArgs ka = kargs(); a_gather(C, WSP(const bf16, WS_QKV), ka->in[2], WSP(const unsigned, WS_SEL), WSP(float, WS_PO), WSP(float, WS_PML)); }
        GRID_BAR();
        }
        REP(RP_M) {
        { const Ctx C = make_ctx(lds); const KArgs ka = kargs(); t_merge_norm(C, WSP(const unsigned, WS_SEL), WSP(const float, WS_PO), WSP(const float, WS_PML), WSP(const bf16, WS_O), (rep_ + 1 < RP_M) ? WSP(bf16, WS_DUMMY) : WSP(bf16, WS_O), ka->in[14] + (size_t)l * D); }
        GRID_BAR();
        }
#else
        REP(1) {
        { const Ctx C = make_ctx(lds); const KArgs ka = kargs(); t_groupnorm(C, WSP(bf16, WS_O), ka->in[14] + (size_t)l * D); }
        GRID_BAR();
        }
#endif
        REP(RP_G) {
        { const Ctx C = make_ctx(lds); const KArgs ka = kargs(); const LayerW w = layer_w(ka->ws, l);
          pg8::Gemm g{WSP(const bf16, WS_O), w.wout, M, D, D}; pg8::StaticOrder S; S.init(M, D, C.G, C.bid); pg8::EpiF32 E{WSP(float, WS_Y), D};
          pg8::gemm_phase<pg8::EpiF32, pg8::StaticOrder, true, true>(C.lds + RING_OFF, g, S, E); }
        GRID_BAR();
        }
        REP(RP_T) {
        { const Ctx C = make_ctx(lds); const KArgs ka = kargs(); const float* modl = WSP(const float, WS_MOD) + (size_t)l * 2 * NMOD;
          t_post(C, ka->out, (rep_ + 1 < RP_T) ? WSP(float, WS_DUMMY) : ka->out, WSP(const float, WS_Y), ka->in[6] + (size_t)(l * 3 + 1) * D, modl, 3, 1.0f, ka->in[5] + (size_t)(l * 3 + 2) * D, modl, 6, WSP(bf16, WS_XN)); }
        GRID_BAR();
        }
        REP(RP_G) {
        { const Ctx C = make_ctx(lds); const KArgs ka = kargs(); const LayerW w = layer_w(ka->ws, l);
          pg8::Gemm g{WSP(const bf16, WS_XN), w.wgu1, M, NGU, D}; pg8::StaticOrder S; S.init(M, NGU, C.G, C.bid); pg8::EpiSwiGLU E{WSP(bf16, WS_H), FF};
          pg8::gemm_phase<pg8::EpiSwiGLU, pg8::StaticOrder, true, true>(C.lds + RING_OFF, g, S, E); }
        GRID_BAR();
        }
        REP(RP_G) {
        { const Ctx C = make_ctx(lds); const KArgs ka = kargs(); const LayerW w = layer_w(ka->ws, l);
          pg8::Gemm g{WSP(const bf16, WS_H), w.wd1, M, D, FF}; pg8::StaticOrder S; S.init(M, D, C.G, C.bid); pg8::EpiF32 E{WSP(float, WS_Y), D};
          pg8::gemm_phase<pg8::EpiF32, pg8::StaticOrder, true, true>(C.lds + RING_OFF, g, S, E); }
        GRID_BAR();
        }
        REP(RP_T) {
        { const Ctx C = make_ctx(lds); const KArgs ka = kargs(); const float* modl = WSP(const float, WS_MOD) + (size_t)l * 2 * NMOD;
          t_post(C, ka->out, (rep_ + 1 < RP_T) ? WSP(float, WS_DUMMY) : ka->out, WSP(const float, WS_Y), ka->in[6] + (size_t)(l * 3 + 2) * D, modl, 6, 0.5f, (l + 1 < DEPTH) ? ka->in[5] + (size_t)((l + 1) * 3) * D : nullptr, modl + 2 * NMOD, 0, WSP(bf16, WS_XN)); }
        GRID_BAR();
        }
    }
}

extern "C" void kernel_launch(void* const* d_in, const int* in_sizes, int n_in, void* d_out, int out_size, void* d_ws, size_t ws_size, hipStream_t stream) {
    static int grid = 0;
    if (grid == 0) {
        if (n_in != 15 || in_sizes[0] != M * D || out_size != M * D || ws_size < WS_END) { fprintf(stderr, "kernel_launch: unexpected shapes (n_in %d, in0 %d, out %d, ws %zu)\n", n_in, n_in > 0 ? in_sizes[0] : -1, out_size, ws_size); grid = -1; return; }
        int dev = 0, cus = 0, per_cu = 0;
        if (hipGetDevice(&dev) != hipSuccess || hipDeviceGetAttribute(&cus, hipDeviceAttributeMultiprocessorCount, dev) != hipSuccess) { grid = -1; return; }
        if (hipFuncSetAttribute((const void*)trunk_fwd, hipFuncAttributeMaxDynamicSharedMemorySize, LDS_BYTES) != hipSuccess) { fprintf(stderr, "kernel_launch: hipFuncSetAttribute failed\n"); grid = -1; return; }
        if (hipOccupancyMaxActiveBlocksPerMultiprocessor(&per_cu, (const void*)trunk_fwd, NTHR, LDS_BYTES) != hipSuccess || per_cu < 1) { fprintf(stderr, "kernel_launch: occupancy query reports %d blocks per CU\n", per_cu); }
        (void)hipGetLastError();
        grid = cus;
    }
    if (grid < 0) return;
    if (hipMemsetAsync((char*)d_ws + WS_CTL, 0, CTL_ZERO_BYTES, stream) != hipSuccess) return;
    Args a{};
    for (int i = 0; i < 15; ++i) a.in[i] = (const float*)d_in[i];
    a.out = (float*)d_out; a.ws = (unsigned char*)d_ws;
    hipLaunchKernelGGL(trunk_fwd, dim3(grid), dim3(NTHR), LDS_BYTES, stream, a);
}
```
